# Optimizing an MI355X kernel written in HIP

```python
import jax, jax.numpy as jnp
from jax import lax
import numpy as np

D_MODEL = 1024
BATCH = 8
SEQ = 4096
DEPTH = 1

N_RET_HEADS = 4
RET_QK_DIM = 128
RET_V_DIM = 2 * RET_QK_DIM
RET_QK_W = N_RET_HEADS * RET_QK_DIM
RET_V_W = N_RET_HEADS * RET_V_DIM
CHUNK = 128
ROPE_BASE = 10000.0
POOL_WINDOWS = (2, 4, 8, 16)
POOL_GROUPS = len(POOL_WINDOWS)
POOL_GROUP_DIM = 128
POOL_W = POOL_GROUPS * POOL_GROUP_DIM
D_FF = 4 * D_MODEL
IN_COLS = 2 * RET_QK_W + 2 * RET_V_W + POOL_W + 2 * D_MODEL
EPS = 1e-6

kernel_name = "hybrid_retention_pool_gated_block"


def rmsnorm(x, g):
    xf = x.astype(jnp.float32)
    y = xf * lax.rsqrt(jnp.mean(xf * xf, axis=-1, keepdims=True) + EPS)
    return (y * g.astype(jnp.float32)).astype(x.dtype)


def rotary(x, pos):
    half = x.shape[-1] // 2
    inv_freq = ROPE_BASE ** (-jnp.arange(half, dtype=jnp.float32) * 2.0 / x.shape[-1])
    ang = pos.astype(jnp.float32)[:, None] * inv_freq[None, :]
    cos = jnp.cos(ang)[None, :, None, :]
    sin = jnp.sin(ang)[None, :, None, :]
    x1, x2 = x[..., :half], x[..., half:]
    return jnp.concatenate([x1 * cos - x2 * sin, x1 * sin + x2 * cos], axis=-1)


def retention_chunkwise(q, k, v):
    B, S, H, dk = q.shape
    dv = v.shape[-1]
    N = S // CHUNK
    log_gamma = jnp.log(1.0 - jnp.exp2(-5.0 - jnp.arange(H, dtype=jnp.float32)))
    qc = q.reshape(B, N, CHUNK, H, dk)
    kc = k.reshape(B, N, CHUNK, H, dk)
    vc = v.reshape(B, N, CHUNK, H, dv)
    idx = jnp.arange(CHUNK, dtype=jnp.float32)
    diff = idx[:, None] - idx[None, :]
    inner_decay = jnp.where(diff[None] >= 0,
                            jnp.exp(log_gamma[:, None, None] * jnp.maximum(diff, 0.0)[None]), 0.0)
    scores = jnp.einsum('bnchd,bnmhd->bnhcm', qc, kc) * inner_decay[None, None]
    inner = jnp.einsum('bnhcm,bnmhe->bnche', scores, vc)
    zeta = jnp.exp(log_gamma[:, None] * (CHUNK - 1.0 - idx)[None, :])
    xi = jnp.exp(log_gamma[:, None] * (idx + 1.0)[None, :])
    chunk_kv = jnp.einsum('bnmhd,hm,bnmhe->nbhde', kc, zeta, vc)
    chunk_decay = jnp.exp(log_gamma * CHUNK)[None, :, None, None]

    def step(state, kv):
        return state * chunk_decay + kv, state

    init = jnp.zeros((B, H, dk, dv), jnp.float32)
    _, prev_states = lax.scan(step, init, chunk_kv)
    cross = jnp.einsum('bnchd,hc,nbhde->bnche', qc, xi, prev_states)
    return (inner + cross).reshape(B, S, H, dv)


def multiscale_pool(u, w_grp, scale):
    B, S, _ = u.shape
    uf = u.astype(jnp.float32)
    cs = jnp.cumsum(uf, axis=1)
    t = jnp.arange(S)
    outs = []
    for g, w in enumerate(POOL_WINDOWS):
        sl = slice(g * POOL_GROUP_DIM, (g + 1) * POOL_GROUP_DIM)
        csg = cs[..., sl]
        shifted = jnp.pad(csg, ((0, 0), (w, 0), (0, 0)))[:, :S]
        cnt = jnp.minimum(t + 1, w).astype(jnp.float32)[None, :, None]
        outs.append((csg - shifted) / cnt - uf[..., sl])
    p = jnp.stack(outs, axis=2)
    y = jnp.einsum('bsgc,gcd->bsgd', p, w_grp.astype(jnp.float32)).reshape(B, S, POOL_W)
    return (y * scale.astype(jnp.float32)).astype(u.dtype)


def hybrid_layer(x, ln_mix, w_in, b_gate, gn_gain, w_ret_up, pool_w, pool_scale,
                 w_pool_up, w_o, ln_mlp, w_up, w_down):
    B, S, D = x.shape
    h = rmsnorm(x, ln_mix)
    z = h @ w_in
    o = 0
    q = z[..., o:o + RET_QK_W]; o += RET_QK_W
    k = z[..., o:o + RET_QK_W]; o += RET_QK_W
    v = z[..., o:o + RET_V_W]; o += RET_V_W
    g = z[..., o:o + RET_V_W]; o += RET_V_W
    pu = z[..., o:o + POOL_W]; o += POOL_W
    gate_logits = z[..., o:o + 2 * D]

    pos = jnp.arange(S)
    qh = rotary(q.astype(jnp.float32).reshape(B, S, N_RET_HEADS, RET_QK_DIM), pos) * (RET_QK_DIM ** -0.5)
    kh = rotary(k.astype(jnp.float32).reshape(B, S, N_RET_HEADS, RET_QK_DIM), pos)
    vh = v.astype(jnp.float32).reshape(B, S, N_RET_HEADS, RET_V_DIM)
    ret = retention_chunkwise(qh, kh, vh)
    mu = jnp.mean(ret, axis=-1, keepdims=True)
    var = jnp.mean(jnp.square(ret - mu), axis=-1, keepdims=True)
    ret_n = ((ret - mu) * lax.rsqrt(var + EPS)).reshape(B, S, RET_V_W) * gn_gain.astype(jnp.float32)
    y_ret = (jax.nn.silu(g.astype(jnp.float32)) * ret_n).astype(x.dtype) @ w_ret_up

    y_pool = multiscale_pool(pu, pool_w, pool_scale) @ w_pool_up

    gates = jax.nn.sigmoid(gate_logits + b_gate)
    mixed = gates[..., :D] * y_ret + gates[..., D:] * y_pool
    x = x + mixed @ w_o

    h2 = rmsnorm(x, ln_mlp)
    x = x + jnp.square(jax.nn.relu(h2 @ w_up)) @ w_down
    return x


def setup_inputs(seed: int = 0) -> dict:
    key = jax.random.key(seed)
    ks = jax.random.split(key, 16)
    L = DEPTH
    f32 = jnp.float32

    def nrm(k, shape, fan_in):
        return jax.random.normal(k, shape, f32) * (fan_in ** -0.5)

    def gain(k, shape):
        return 1.0 + 0.02 * jax.random.normal(k, shape, f32)

    return {
        "x": jax.random.normal(ks[0], (BATCH, SEQ, D_MODEL), f32),
        "ln_mix": gain(ks[1], (L, D_MODEL)),
        "w_in": nrm(ks[2], (L, D_MODEL, IN_COLS), D_MODEL),
        "b_gate": 0.02 * jax.random.normal(ks[3], (L, 2 * D_MODEL), f32),
        "gn_gain": gain(ks[4], (L, RET_V_W)),
        "w_ret_up": nrm(ks[5], (L, RET_V_W, D_MODEL), RET_V_W),
        "pool_w": nrm(ks[6], (L, POOL_GROUPS, POOL_GROUP_DIM, POOL_GROUP_DIM), POOL_GROUP_DIM),
        "pool_scale": gain(ks[7], (L, POOL_W)),
        "w_pool_up": nrm(ks[8], (L, POOL_W, D_MODEL), POOL_W),
        "w_o": nrm(ks[9], (L, D_MODEL, D_MODEL), D_MODEL),
        "ln_mlp": gain(ks[10], (L, D_MODEL)),
        "w_up": nrm(ks[11], (L, D_MODEL, D_FF), D_MODEL),
        "w_down": nrm(ks[12], (L, D_FF, D_MODEL), D_FF),
        "ln_final": gain(ks[13], (D_MODEL,)),
    }


def reference(x, ln_mix, w_in, b_gate, gn_gain, w_ret_up, pool_w, pool_scale,
              w_pool_up, w_o, ln_mlp, w_up, w_down, ln_final):
    for l in range(DEPTH):
        x = hybrid_layer(x, ln_mix[l], w_in[l], b_gate[l], gn_gain[l], w_ret_up[l],
                         pool_w[l], pool_scale[l], w_pool_up[l], w_o[l], ln_mlp[l],
                         w_up[l], w_down[l])
    return rmsnorm(x, ln_final)
```

```cpp
#include <hip/hip_runtime.h>
#include <cstdio>
#include <cstdint>
#include <cmath>

#ifndef MK_N_LAUNCHES
#define MK_N_LAUNCHES 1
#endif
constexpr int N_PHASES = 9;
constexpr int N_LAUNCHES = MK_N_LAUNCHES;
static_assert(N_LAUNCHES == 1 || N_LAUNCHES == N_PHASES, "MK_N_LAUNCHES is 1 or 9");

namespace pg8 {
#define PG8_LAS __attribute__((address_space(3)))
typedef unsigned short bf16_t;
typedef short bf16x8 __attribute__((ext_vector_type(8)));
typedef float f32x4 __attribute__((ext_vector_type(4)));
typedef unsigned u32x4 __attribute__((ext_vector_type(4)));
typedef unsigned u32x2 __attribute__((ext_vector_type(2)));
constexpr int BM = 256, BK = 64, HALF = 128, HTB = HALF * BK * 2, STAGE_BYTES = 8 * HTB, NXCD = 8, WGM = 8;

__host__ __device__ __forceinline__ int lds_byte(int r, int c) { const int st = (r >> 4) * 2 + (c >> 5), rr = r & 15, cc = c & 31, ob = rr * 64 + cc * 2; return st * 1024 + (ob ^ (((ob >> 9) & 1) << 5)); }
__host__ __device__ __forceinline__ void stage_rc(int b, int& R, int& C) { const int st = b / 1024, sb = b % 1024, swz = sb ^ (((sb >> 9) & 1) << 5); R = (st >> 1) * 16 + swz / 64; C = (st & 1) * 32 + (swz % 64) / 2; }
__host__ __device__ __forceinline__ int perm32(int rho) { const int n = rho >> 4, i = rho & 15; return 8 * (i >> 2) + 4 * n + (i & 3); }

struct Unit { int pm, pn; };
struct Gemm { const bf16_t* A; const bf16_t* Bt; int M, N, K; };

template <int M_, int N_> struct StaticOrder {
    static constexpr int nM = M_ / BM, nN = N_ / BM, nwg = nM * nN;
    int G, c;
    __host__ __device__ void init(int G_, int c_) { G = G_; c = c_; }
    __host__ __device__ bool next(int i, Unit& u) const {
        const long L = (long)i * G + c; if (L >= nwg) return false;
        int wgid = (int)L; { const int q = nwg / NXCD, r = nwg % NXCD, xcd = wgid % NXCD, off = wgid / NXCD; wgid = (xcd < r ? xcd * (q + 1) : r * (q + 1) + (xcd - r) * q) + off; }
        static_assert(nM % WGM == 0 || nM < WGM, "row-tile groups are all the same size");
        constexpr int gsz = (nM < WGM) ? nM : WGM, nig = gsz * nN; const int gid = wgid / nig, fm = gid * gsz;
        u.pm = fm + ((wgid % nig) % gsz); u.pn = (wgid % nig) / gsz; return true;
    }
    __device__ __forceinline__ void a_ready(const Unit&) const {}
    __device__ __forceinline__ void done(const Unit&) const {}
};

typedef __bf16 bf16x2_t __attribute__((ext_vector_type(2)));
typedef float f32x2_t __attribute__((ext_vector_type(2)));
__device__ __forceinline__ unsigned cvt_pk_bf16(float lo, float hi) { const f32x2_t v = {lo, hi}; const bf16x2_t b = __builtin_convertvector(v, bf16x2_t); return __builtin_bit_cast(unsigned, b); }
__device__ __forceinline__ u32x4 pack8(const f32x4 a, const f32x4 b) { u32x4 w; w.x = cvt_pk_bf16(a[0], a[1]); w.y = cvt_pk_bf16(a[2], a[3]); w.z = cvt_pk_bf16(b[0], b[1]); w.w = cvt_pk_bf16(b[2], b[3]); return w; }
__device__ __forceinline__ float bf_lo(unsigned w) { return __uint_as_float(w << 16); }
__device__ __forceinline__ float bf_hi(unsigned w) { return __uint_as_float(w & 0xffff0000u); }

template <class Epi, class Sched, int K, bool ALIGN_EPI = false, bool SP2 = false>
__device__ __forceinline__ void gemm_phase(PG8_LAS unsigned char* lds, const Gemm g, const Sched& S, const Epi& E) {
    int tid = threadIdx.x; asm volatile("" : "+v"(tid));
    const int wid = __builtin_amdgcn_readfirstlane(tid >> 6), lane = tid & 63, wr = wid >> 2, wc = wid & 3, fr = lane & 15, fq = lane >> 4;
    constexpr int nt = K / BK;
    unsigned voffA[2], voffB[2];
#pragma unroll
    for (int i = 0; i < 2; ++i) { int R, C; stage_rc(tid * 16 + i * 8192, R, C); const int Rb = Epi::PERM ? ((R & ~31) + perm32(R & 31)) : R;
        voffA[i] = (unsigned)(R * K + C) * 2u; voffB[i] = (unsigned)(Rb * K + C) * 2u; }
    constexpr size_t kstep = (size_t)(BK * 2);
    constexpr size_t hstep = (size_t)HALF * K * 2;
    constexpr size_t tstep = 2 * hstep;
    const unsigned ldsw = (unsigned)wid * 1024u;
    const int aoff = lds_byte(wr * 64 + fr, fq * 8), boff = lds_byte(wc * 32 + fr, fq * 8);
#define PG8_SA(b, h) (((b) * 2 + (h)) * HTB)
#define PG8_SB(b, h) ((4 + (b) * 2 + (h)) * HTB)
#define PG8_STAGE(bufoff, gbase, voff) do { _Pragma("unroll") for (int _i = 0; _i < 2; ++_i) \
        __builtin_amdgcn_global_load_lds((const unsigned*)((const char*)(gbase) + (voff)[_i]), (PG8_LAS unsigned*)(lds + (bufoff) + ldsw + _i * 8192), 16, 0, 0); } while (0)
#define PG8_LDA(dst, b, h) do { _Pragma("unroll") for (int m = 0; m < 4; ++m) _Pragma("unroll") for (int k = 0; k < 2; ++k) dst[m][k] = *(const PG8_LAS bf16x8*)(lds + PG8_SA(b, h) + aoff + m * 2048 + k * 1024); } while (0)
#define PG8_LDB(dst, b, h) do { _Pragma("unroll") for (int n = 0; n < 2; ++n) _Pragma("unroll") for (int k = 0; k < 2; ++k) dst[n][k] = *(const PG8_LAS bf16x8*)(lds + PG8_SB(b, h) + boff + n * 2048 + k * 1024); } while (0)
#define PG8_MMA(ai, bj, At, Bt) do { __builtin_amdgcn_s_setprio(1); _Pragma("unroll") for (int m = 0; m < 4; ++m) _Pragma("unroll") for (int n = 0; n < 2; ++n) _Pragma("unroll") for (int k = 0; k < 2; ++k) \
        acc[ai][bj][m][n] = __builtin_amdgcn_mfma_f32_16x16x32_bf16(Bt[n][k], At[m][k], acc[ai][bj][m][n], 0, 0, 0); __builtin_amdgcn_s_setprio(0); } while (0)
#define PG8_WAIT_V(n) asm volatile("s_waitcnt vmcnt(" #n ")" ::: "memory")
#define PG8_WAIT_L(n) asm volatile("s_waitcnt lgkmcnt(" #n ")" ::: "memory")
#define PG8_BAR __builtin_amdgcn_s_barrier()
#define PG8_SCHED __builtin_amdgcn_sched_barrier(0)
    Unit cur, nxt; int ui = 0;
    if (!S.next(0, cur)) return;
    f32x4 acc[2][2][4][2];
#pragma unroll
    for (int a = 0; a < 2; ++a)
#pragma unroll
        for (int b = 0; b < 2; ++b)
#pragma unroll
            for (int m = 0; m < 4; ++m)
#pragma unroll
                for (int n = 0; n < 2; ++n) acc[a][b][m][n] = (f32x4){0.f, 0.f, 0.f, 0.f};
    bf16x8 At[4][2], B0[2][2], B1[2][2];
    const char* cA = (const char*)g.A + (size_t)cur.pm * tstep; const char* cB = (const char*)g.Bt + (size_t)cur.pn * tstep;
    S.a_ready(cur);
    if constexpr (SP2) {
        PG8_STAGE(PG8_SB(0, 0), cB, voffB); PG8_STAGE(PG8_SB(0, 1), cB + hstep, voffB); PG8_STAGE(PG8_SA(0, 0), cA, voffA); PG8_STAGE(PG8_SA(0, 1), cA + hstep, voffA);
        if (wr == 1) PG8_BAR;
        PG8_WAIT_V(2); PG8_BAR;
        PG8_STAGE(PG8_SB(1, 0), cB + kstep, voffB); PG8_STAGE(PG8_SA(1, 0), cA + kstep, voffA); PG8_STAGE(PG8_SB(1, 1), cB + hstep + kstep, voffB);
        PG8_WAIT_V(6); PG8_BAR;
    } else {
        PG8_STAGE(PG8_SB(0, 0), cB, voffB); PG8_STAGE(PG8_SA(0, 0), cA, voffA); PG8_STAGE(PG8_SB(0, 1), cB + hstep, voffB); PG8_STAGE(PG8_SA(0, 1), cA + hstep, voffA);
        if (wr == 1) PG8_BAR;
        PG8_WAIT_V(4); PG8_BAR;
        PG8_STAGE(PG8_SB(1, 0), cB + kstep, voffB); PG8_STAGE(PG8_SA(1, 0), cA + kstep, voffA); PG8_STAGE(PG8_SB(1, 1), cB + hstep + kstep, voffB);
        PG8_WAIT_V(6); PG8_BAR;
    }
    for (;;) {
        const bool has_next = S.next(ui + 1, nxt);
        const char* nA = has_next ? (const char*)g.A + (size_t)nxt.pm * tstep : cA; const char* nB = has_next ? (const char*)g.Bt + (size_t)nxt.pn * tstep : cB;
        for (int t = 0; t < nt; t += 2) {
            if constexpr (Epi::MID_T > 0) { if (t == Epi::MID_T) E.mid(acc, cur, wr, wc, fr, fq); }
            const bool last = (t == nt - 2);
            const char* a1 = cA + (size_t)(t + 1) * kstep;
            const char* a2 = last ? nA : cA + (size_t)(t + 2) * kstep; const char* b2 = last ? nB : cB + (size_t)(t + 2) * kstep;
            const char* a3 = a2 + kstep; const char* b3 = b2 + kstep;
            if (last && has_next) S.a_ready(nxt);
            if constexpr (SP2) {
            PG8_LDB(B0, 0, 0); PG8_LDB(B1, 0, 1); PG8_SCHED; PG8_LDA(At, 0, 0); PG8_STAGE(PG8_SA(1, 1), a1 + hstep, voffA);
            PG8_WAIT_V(8); PG8_WAIT_L(0); PG8_BAR; PG8_MMA(0, 0, At, B0); PG8_MMA(0, 1, At, B1); PG8_BAR; PG8_SCHED;
            PG8_LDA(At, 0, 1); PG8_STAGE(PG8_SB(0, 0), b2, voffB); PG8_STAGE(PG8_SB(0, 1), b2 + hstep, voffB); PG8_STAGE(PG8_SA(0, 0), a2, voffA);
            PG8_WAIT_V(8); PG8_WAIT_L(0); PG8_BAR; PG8_MMA(1, 0, At, B0); PG8_MMA(1, 1, At, B1); PG8_BAR; PG8_SCHED;
            PG8_LDB(B0, 1, 0); PG8_LDB(B1, 1, 1); PG8_SCHED; PG8_LDA(At, 1, 0); PG8_STAGE(PG8_SA(0, 1), a2 + hstep, voffA);
            PG8_WAIT_V(8); PG8_WAIT_L(0); PG8_BAR; PG8_MMA(0, 0, At, B0); PG8_MMA(0, 1, At, B1); PG8_BAR; PG8_SCHED;
            PG8_LDA(At, 1, 1); PG8_STAGE(PG8_SB(1, 0), b3, voffB); PG8_STAGE(PG8_SB(1, 1), b3 + hstep, voffB); PG8_STAGE(PG8_SA(1, 0), a3, voffA);
            PG8_WAIT_V(8); PG8_WAIT_L(0); PG8_BAR; PG8_MMA(1, 0, At, B0); PG8_MMA(1, 1, At, B1); PG8_BAR; PG8_SCHED;
            } else {
            PG8_LDB(B0, 0, 0); PG8_SCHED; PG8_LDA(At, 0, 0); PG8_STAGE(PG8_SA(1, 1), a1 + hstep, voffA);
            PG8_WAIT_L(8); PG8_BAR; PG8_WAIT_L(0); PG8_MMA(0, 0, At, B0); PG8_BAR; PG8_SCHED;
            PG8_LDB(B1, 0, 1); PG8_STAGE(PG8_SB(0, 0), b2, voffB);
            PG8_BAR; PG8_WAIT_L(0); PG8_MMA(0, 1, At, B1); PG8_BAR;
            PG8_LDA(At, 0, 1); PG8_STAGE(PG8_SA(0, 0), a2, voffA);
            PG8_BAR; PG8_WAIT_L(0); PG8_MMA(1, 0, At, B0); PG8_BAR; PG8_SCHED;
            PG8_STAGE(PG8_SB(0, 1), b2 + hstep, voffB);
            PG8_WAIT_V(6); PG8_BAR; PG8_MMA(1, 1, At, B1); PG8_BAR;
            PG8_LDB(B0, 1, 0); PG8_SCHED; PG8_LDA(At, 1, 0); PG8_STAGE(PG8_SA(0, 1), a2 + hstep, voffA);
            PG8_WAIT_L(8); PG8_BAR; PG8_WAIT_L(0); PG8_MMA(0, 0, At, B0); PG8_BAR; PG8_SCHED;
            PG8_LDB(B1, 1, 1); PG8_STAGE(PG8_SB(1, 0), b3, voffB);
            PG8_BAR; PG8_WAIT_L(0); PG8_MMA(0, 1, At, B1); PG8_BAR;
            PG8_LDA(At, 1, 1); PG8_STAGE(PG8_SA(1, 0), a3, voffA);
            PG8_BAR; PG8_WAIT_L(0); PG8_MMA(1, 0, At, B0); PG8_BAR; PG8_SCHED;
            PG8_STAGE(PG8_SB(1, 1), b3 + hstep, voffB);
            PG8_WAIT_V(6); PG8_BAR; PG8_MMA(1, 1, At, B1); PG8_BAR;
            }
        }
        if constexpr (ALIGN_EPI) { if (wr == 0) PG8_BAR; }
        E(acc, cur, wr, wc, fr, fq); S.done(cur);
        if (!has_next) break;
#pragma unroll
        for (int a = 0; a < 2; ++a)
#pragma unroll
            for (int b = 0; b < 2; ++b)
#pragma unroll
                for (int m = 0; m < 4; ++m)
#pragma unroll
                    for (int n = 0; n < 2; ++n) acc[a][b][m][n] = (f32x4){0.f, 0.f, 0.f, 0.f};
        cur = nxt; cA = nA; cB = nB; ++ui;
        if constexpr (ALIGN_EPI) { if (wr == 1) PG8_BAR; }
    }
    PG8_WAIT_V(0);
    if constexpr (!ALIGN_EPI) { if (wr == 0) PG8_BAR; }
    PG8_BAR;
#undef PG8_SA
#undef PG8_SB
#undef PG8_STAGE
#undef PG8_LDA
#undef PG8_LDB
#undef PG8_MMA
#undef PG8_WAIT_V
#undef PG8_WAIT_L
#undef PG8_BAR
#undef PG8_SCHED
}
}

#ifndef PG8_SP2
#define PG8_SP2 true
#endif
#ifndef PG8_ALIGN
#define PG8_ALIGN true
#endif

constexpr int NWAVES = 8;
constexpr int BATCH = 8, SEQ = 4096, DM = 1024, MTOK = BATCH * SEQ;
constexpr int NH = 4, DK = 128, DV = 256, QKW = 512, VW = 1024, CHUNK = 128, NCH = SEQ / CHUNK;
constexpr int PW = 512, DFF = 4096, INC = 5632;
constexpr int ZQ = 0, ZK = 512, ZV = 1024, ZG = 2048, ZPU = 3072, ZGT = 3584;
constexpr int N1 = 4608;
constexpr int M2 = 1536;
constexpr int K4 = 1536;
constexpr float EPS = 1e-6f;

constexpr size_t MiB = 1u << 20;
constexpr size_t WS_CTL = 0, CTL_ZERO_BYTES = 1 * MiB;
constexpr size_t WS_SS2 = 256 * 1024, WS_SS3 = 384 * 1024;
constexpr size_t WS_T1 = 2 * MiB;
constexpr size_t WS_T2C = 4 * MiB, WS_T2S = 5 * MiB;
constexpr size_t WS_DEC = 6 * MiB;
constexpr size_t WS_BT1 = 8 * MiB, WS_WT2 = 17 * MiB, WS_BT4 = 20 * MiB, WS_BT5 = 23 * MiB, WS_BT6 = 25 * MiB, WS_BT7 = 33 * MiB;
constexpr size_t WS_XN = 48 * MiB, WS_ST = 48 * MiB;
constexpr size_t WS_Q = 112 * MiB, WS_K = 144 * MiB, WS_KT = 176 * MiB, WS_VS = 208 * MiB, WS_SG = 272 * MiB, WS_PU = 336 * MiB, WS_GT = 368 * MiB;
constexpr size_t WS_MIX = 112 * MiB;
constexpr size_t WS_HID = 48 * MiB;
constexpr size_t WS_X1B = 304 * MiB, WS_X1 = 368 * MiB;
constexpr size_t WS_END = 496 * MiB;
static_assert(WS_BT7 + 8 * MiB <= WS_XN && WS_HID + 256 * MiB <= WS_X1B && WS_X1B + 64 * MiB <= WS_X1 && WS_X1 + 128 * MiB <= WS_END, "ws map");
constexpr int CW_TMO = 0, CW_CODE = 1, CW_BAR = 4096;
constexpr int RPITCH = K4;

constexpr int RING_OFF = 0, RING_BYTES = 131072;
constexpr int LDSCTL_OFF = RING_BYTES, MISC_OFF = LDSCTL_OFF + 320;
constexpr int LDS_BYTES = 147456;

#define GAS __attribute__((address_space(1)))
#define LAS __attribute__((address_space(3)))
typedef unsigned short bf16;
typedef unsigned v4u __attribute__((ext_vector_type(4)));
typedef unsigned v2u __attribute__((ext_vector_type(2)));
typedef float f32x4 __attribute__((ext_vector_type(4)));
typedef short bf16x8 __attribute__((ext_vector_type(8)));
typedef GAS unsigned gu32;
#define RLX_AGENT __ATOMIC_RELAXED, __HIP_MEMORY_SCOPE_AGENT
#define LDS_WAIT() asm volatile("s_waitcnt lgkmcnt(0)" ::: "memory")
#define VM_WAIT() asm volatile("s_waitcnt vmcnt(0)" ::: "memory")
__device__ __forceinline__ unsigned f2bf(float f) { unsigned u = __builtin_bit_cast(unsigned, f); return (u + 0x7fffu + ((u >> 16) & 1u)) >> 16; }
__device__ __forceinline__ unsigned pk2(float lo, float hi) { return f2bf(lo) | (f2bf(hi) << 16); }
using pg8::cvt_pk_bf16; using pg8::pack8; using pg8::bf_lo; using pg8::bf_hi;

#define XB_TMO      128
#define XB_XCNT(j)  (256  + 64 * (j))
#define XB_XSUB(j)  (1280 + 64 * (j))
#define XB_XGEN(j)  (2304 + 64 * (j))
#define XB_TOP      3328
#define XB_TOPGEN   3392
#define XCD_BAR_WORDS 3456
#define XB_SPIN_CAP (1u << 18)
__device__ __forceinline__ unsigned xb_ld(unsigned* p)              { return __hip_atomic_load(p, __ATOMIC_RELAXED, __HIP_MEMORY_SCOPE_AGENT); }
__device__ __forceinline__ unsigned xb_add(unsigned* p, unsigned v) { return __hip_atomic_fetch_add(p, v, __ATOMIC_RELAXED, __HIP_MEMORY_SCOPE_AGENT); }
__device__ __forceinline__ unsigned xb_xcc_id() { return (unsigned)__builtin_amdgcn_s_getreg((3 << 11) | 20) & 0xFu; }
#define XB_SPIN(cond, bar) do { unsigned _sp = 0; while (cond) { __builtin_amdgcn_s_sleep(1); \
    if ((++_sp & 255u) == 0u) { if (xb_ld(&(bar)[XB_TMO])) break; if (_sp > XB_SPIN_CAP) { atomicAdd(&(bar)[XB_TMO], 1u); break; } } } } while (0)
struct XcdBarrier { unsigned* bar; unsigned x; volatile LAS unsigned* st; };
__device__ __forceinline__ XcdBarrier xcd_barrier_post(unsigned* bar, volatile LAS unsigned* st) {
    XcdBarrier b; b.bar = bar; b.x = xb_xcc_id(); b.st = st;
    if (threadIdx.x == 0) (void)xb_add(&bar[XB_XCNT(b.x)], 1u);
    return b;
}
__device__ __forceinline__ void xcd_barrier_complete(unsigned* bar, unsigned x, unsigned& nloc, unsigned& nx) {
    const unsigned G = gridDim.x * gridDim.y * gridDim.z;
    unsigned sum, cnt, mine, sp = 0u;
    for (;;) {
        sum = 0u; cnt = 0u; mine = 0u;
#pragma unroll
        for (unsigned j = 0; j < 16; ++j) { const unsigned c = xb_ld(&bar[XB_XCNT(j)]); sum += c; cnt += (c > 0u) ? 1u : 0u; mine = (j == x) ? c : mine; }
        if (sum == G) break;
        __builtin_amdgcn_s_sleep(1);
        if ((++sp & 255u) == 0u) { if (xb_ld(&bar[XB_TMO])) break; if (sp > XB_SPIN_CAP) { atomicAdd(&bar[XB_TMO], 1u); break; } }
    }
    nloc = mine > 0u ? mine : 1u; nx = cnt > 0u ? cnt : 1u;
}
__device__ __forceinline__ void xcd_barrier(const XcdBarrier& b) {
    asm volatile("s_waitcnt vmcnt(0)" ::: "memory");
    __syncthreads();
    if (threadIdx.x == 0) {
        unsigned* bar = b.bar;
        __builtin_amdgcn_s_waitcnt(0);
        unsigned nloc = b.st[0], nx = b.st[1];
        if (nloc == 0u) { xcd_barrier_complete(bar, b.x, nloc, nx); b.st[0] = nloc; b.st[1] = nx; }
        const unsigned old = xb_add(&bar[XB_XSUB(b.x)], 1u);
        const unsigned gen = old / nloc;
        if (old + 1u == (gen + 1u) * nloc) {
            __builtin_amdgcn_fence(__ATOMIC_RELEASE, "agent");
            asm volatile("s_waitcnt vmcnt(0)" ::: "memory");
            const unsigned og = xb_add(&bar[XB_TOP], 1u);
            const unsigned tg = og / nx;
            if (og + 1u == (tg + 1u) * nx) xb_add(&bar[XB_TOPGEN], 1u);
            else XB_SPIN(xb_ld(&bar[XB_TOPGEN]) == tg, bar);
            __builtin_amdgcn_fence(__ATOMIC_ACQUIRE, "agent");
            xb_add(&bar[XB_XGEN(b.x)], 1u);
            asm volatile("s_waitcnt vmcnt(0)" ::: "memory");
        } else {
            XB_SPIN(xb_ld(&bar[XB_XGEN(b.x)]) == gen, bar);
            __builtin_amdgcn_fence(__ATOMIC_ACQUIRE, "agent");
            asm volatile("s_waitcnt vmcnt(0)" ::: "memory");
        }
    }
    __syncthreads();
}

struct Args {
    const float* in[14]; float* out; unsigned char* ws;
    double invf[64];
    float lg[4], g1[4], g127[4], g128[4];
    int ph_lo, ph_hi;
};
struct Frame {
    LAS unsigned char* lds; gu32* ctl;
    int tid, lane, wave, vcu, G;
    unsigned char* ws; float* out;
};
__device__ __forceinline__ float wave_sum(float v) {
#pragma unroll
    for (int o = 1; o < 64; o <<= 1) v += __shfl_xor(v, o);
    return v;
}

__device__ __forceinline__ void tr_item(const float* W, int ldw, int k0, int scol0, const float* kscale, bf16* WT, int dpitch, int drow0, LAS float* scr, int lane) {
#pragma unroll 8
    for (int i = 0; i < 32; ++i) { const int kk = 2 * i + (lane >> 5); float v = W[(size_t)(k0 + kk) * ldw + scol0 + (lane & 31)]; if (kscale) v *= kscale[k0 + kk]; scr[kk * 33 + (lane & 31)] = v; }
    LDS_WAIT(); asm volatile("" ::: "memory");
    const int c = lane & 7;
#pragma unroll
    for (int j = 0; j < 4; ++j) { const int n = (lane >> 3) + 8 * j; const LAS float* s = scr + (8 * c) * 33 + n;
        v4u o; o.x = pk2(s[0 * 33], s[1 * 33]); o.y = pk2(s[2 * 33], s[3 * 33]); o.z = pk2(s[4 * 33], s[5 * 33]); o.w = pk2(s[6 * 33], s[7 * 33]);
        *(GAS v4u*)(WT + (size_t)(drow0 + n) * dpitch + k0 + 8 * c) = o; }
    LDS_WAIT(); asm volatile("" ::: "memory");
}
__device__ __forceinline__ int bt1_src_col(int p0) {
    if (p0 < 1024) { const int pn = p0 >> 8, pp = p0 & 255, bj = pp >> 7, hh = (pp >> 6) & 1, dd0 = pp & 63; return (pn >> 1) * 512 + (pn & 1) * 256 + 128 * hh + 64 * bj + dd0; }
    if (p0 < 2048) return ZG + (p0 - 1024);
    if (p0 < 2560) return ZPU + (p0 - 2048);
    return ZGT + (p0 - 2560);
}
__device__ __forceinline__ int wt2_src_col(int r0) {
    if (r0 < 512) { const int pm = r0 >> 8, rr = r0 & 255, ai = rr >> 7, hh = (rr >> 6) & 1, dd0 = rr & 63; return ZK + pm * 256 + 128 * hh + 64 * ai + dd0; }
    return ZV + (r0 - 512);
}
__device__ __forceinline__ void sincos_d(double ang, float& c, float& s) {
    const double TWO_PI = 6.283185307179586476925286766559, TWO_PI_LO = 2.4492935982947064e-16, INV = 0.15915494309189533576888376337251;
    const double k = __builtin_rint(ang * INV); double r = __builtin_fma(-k, TWO_PI, ang);
    r = __builtin_fma(-k, TWO_PI_LO, r);
    const double HPI = 1.5707963267948966192313216916398;
    const double qd = __builtin_rint(r / HPI); const int qi = (int)qd; const double y = r - qd * HPI;
    const double y2 = y * y;
    double sp = -1.0 / 1307674368000.0; sp = sp * y2 + 1.0 / 6227020800.0; sp = sp * y2 - 1.0 / 39916800.0; sp = sp * y2 + 1.0 / 362880.0; sp = sp * y2 - 1.0 / 5040.0; sp = sp * y2 + 1.0 / 120.0; sp = sp * y2 - 1.0 / 6.0; sp = sp * y2 * y + y;
    double cp = 1.0 / 87178291200.0; cp = cp * y2 - 1.0 / 479001600.0; cp = cp * y2 + 1.0 / 3628800.0; cp = cp * y2 - 1.0 / 40320.0; cp = cp * y2 + 1.0 / 720.0; cp = cp * y2 - 1.0 / 24.0; cp = cp * y2 + 0.5; cp = 1.0 - cp * y2;
    double sv, cv;
    switch (qi & 3) { case 0: sv = sp; cv = cp; break; case 1: sv = cp; cv = -sp; break; case 2: sv = -sp; cv = -cp; break; default: sv = -cp; cv = sp; break; }
    c = (float)cv; s = (float)sv;
}
__device__ __forceinline__ void p0_prologue(Frame& F, const __attribute__((address_space(4))) Args* Ap) {
    const __attribute__((address_space(4))) Args& A = *Ap;
    const float* x = A.in[0]; const float* ln_mix = A.in[1]; const float* w_in = A.in[2]; const float* gn_gain = A.in[4]; const float* w_ret_up = A.in[5];
    const float* pool_w = A.in[6]; const float* pool_scale = A.in[7]; const float* w_pool_up = A.in[8]; const float* w_o = A.in[9]; const float* ln_mlp = A.in[10];
    const float* w_up = A.in[11]; const float* w_down = A.in[12];
    bf16* BT1 = (bf16*)(F.ws + WS_BT1); bf16* WT2 = (bf16*)(F.ws + WS_WT2); bf16* BT4 = (bf16*)(F.ws + WS_BT4); bf16* BT5 = (bf16*)(F.ws + WS_BT5); bf16* BT6 = (bf16*)(F.ws + WS_BT6); bf16* BT7 = (bf16*)(F.ws + WS_BT7);
    LAS float* scr = (LAS float*)(F.lds + RING_OFF + F.wave * 16384);
    const int gw = F.vcu * NWAVES + F.wave, NGW = F.G * NWAVES;
    constexpr int I1 = 16 * (N1 / 32), I2 = 16 * (M2 / 32), I4 = 16 * 32, I5 = 16 * 32, I6 = 16 * (DFF / 32), I7 = 64 * 32;
    constexpr int NITEMS = I1 + I2 + I4 + I5 + I6 + I7;
    for (int it = gw; it < NITEMS; it += NGW) {
        int r = it;
        if (r < I1) { const int nb = r % (N1 / 32), kb = r / (N1 / 32); tr_item(w_in, INC, 64 * kb, bt1_src_col(32 * nb), ln_mix, BT1, DM, 32 * nb, scr, F.lane); continue; } r -= I1;
        if (r < I2) { const int nb = r % (M2 / 32), kb = r / (M2 / 32); tr_item(w_in, INC, 64 * kb, wt2_src_col(32 * nb), ln_mix, WT2, DM, 32 * nb, scr, F.lane); continue; } r -= I2;
        if (r < I4) { const int nb = r % 32, kb = r / 32; tr_item(w_ret_up, DM, 64 * kb, 32 * nb, gn_gain, BT4, K4, 32 * nb, scr, F.lane); continue; } r -= I4;
        if (r < I5) { const int nb = r % 32, kb = r / 32; tr_item(w_o, DM, 64 * kb, 32 * nb, nullptr, BT5, DM, 32 * nb, scr, F.lane); continue; } r -= I5;
        if (r < I6) { const int nb = r % (DFF / 32), kb = r / (DFF / 32); tr_item(w_up, DFF, 64 * kb, 32 * nb, ln_mlp, BT6, DM, 32 * nb, scr, F.lane); continue; } r -= I6;
        { const int nb = r % 32, kb = r / 32; tr_item(w_down, DM, 64 * kb, 32 * nb, nullptr, BT7, DFF, 32 * nb, scr, F.lane); }
    }
    for (int it = gw; it < 4 * 16 * 16; it += NGW) {
        const int g = it >> 8, cb = (it >> 4) & 15, nb = it & 15, n = nb * 64 + F.lane, c0 = cb * 8;
        float a[8];
#pragma unroll
        for (int i = 0; i < 8; ++i) a[i] = 0.f;
        for (int j = 0; j < 128; ++j) {
            const float w = w_pool_up[(size_t)(g * 128 + j) * DM + n] * pool_scale[g * 128 + j];
#pragma unroll
            for (int i = 0; i < 8; ++i) a[i] += pool_w[(size_t)(g * 128 + c0 + i) * 128 + j] * w;
        }
        v4u o; o.x = pk2(a[0], a[1]); o.y = pk2(a[2], a[3]); o.z = pk2(a[4], a[5]); o.w = pk2(a[6], a[7]);
        *(GAS v4u*)(BT4 + (size_t)n * K4 + 1024 + g * 128 + c0) = o;
    }
    bf16* XN = (bf16*)(F.ws + WS_XN);
    for (int m = gw; m < MTOK; m += NGW) {
        const GAS f32x4* xr = (const GAS f32x4*)(x + (size_t)m * DM) + F.lane;
        f32x4 v[4]; float s = 0.f;
#pragma unroll
        for (int j = 0; j < 4; ++j) { v[j] = xr[64 * j]; s += (v[j].x * v[j].x + v[j].y * v[j].y) + (v[j].z * v[j].z + v[j].w * v[j].w); }
        const float rstd = 1.f / sqrtf(wave_sum(s) * (1.f / DM) + EPS);
        GAS unsigned long long* o8 = (GAS unsigned long long*)(XN + (size_t)m * DM) + F.lane;
#pragma unroll
        for (int j = 0; j < 4; ++j) o8[64 * j] = (unsigned long long)pk2(v[j].x * rstd, v[j].y * rstd) | ((unsigned long long)pk2(v[j].z * rstd, v[j].w * rstd) << 32);
    }
    float* T1 = (float*)(F.ws + WS_T1); float* T2C = (float*)(F.ws + WS_T2C); float* T2S = (float*)(F.ws + WS_T2S); float* DEC = (float*)(F.ws + WS_DEC);
    const int gt = F.vcu * NWAVES * 64 + F.tid, NGT = F.G * NWAVES * 64;
    for (int i = gt; i < SEQ * 64; i += NGT) {
        const int pos = i >> 6, dd = i & 63; float c, s; sincos_d((double)pos * A.invf[dd], c, s);
        T1[pos * 128 + dd] = c; T1[pos * 128 + 64 + dd] = s; T2C[dd * SEQ + pos] = c; T2S[dd * SEQ + pos] = s;
    }
    if (gt < 512) { const int h = gt >> 7, m = gt & 127; DEC[gt] = expf(-(float)m * A.lg[h]); }
}

struct EpiIn {
    static constexpr bool PERM = true; static constexpr int MID_T = 0;
    unsigned char* ws; const float* bgate;
    __device__ __forceinline__ void operator()(const f32x4 (&acc)[2][2][4][2], const pg8::Unit& u, int wr, int wc, int fr, int fq) const {
        const int row0 = u.pm * 256 + wr * 64 + fr;
        bf16* const SG = (bf16*)(ws + WS_SG); bf16* const PU = (bf16*)(ws + WS_PU); bf16* const GT = (bf16*)(ws + WS_GT); const float* const T1 = (const float*)(ws + WS_T1);
        if (u.pn < 4) {
            bf16* dst = (bf16*)(ws + ((u.pn < 2) ? WS_Q : WS_K)); const float sc = (u.pn < 2) ? 0.08838834764831845f : 1.0f;
            const int head = 2 * (u.pn & 1) + (wc >> 1), dd0 = 32 * (wc & 1) + 8 * fq;
#pragma unroll
            for (int ai = 0; ai < 2; ++ai)
#pragma unroll
                for (int m = 0; m < 4; ++m) {
                    const int row = row0 + ai * 128 + m * 16; const float* t = T1 + (size_t)(row & (SEQ - 1)) * 128 + dd0;
                    const f32x4 c0 = *(const f32x4*)t, c1 = *(const f32x4*)(t + 4), s0 = *(const f32x4*)(t + 64), s1 = *(const f32x4*)(t + 68);
                    const f32x4 a0 = acc[ai][0][m][0], a1 = acc[ai][0][m][1], b0 = acc[ai][1][m][0], b1 = acc[ai][1][m][1];
                    const f32x4 o10 = (a0 * c0 - b0 * s0) * sc, o11 = (a1 * c1 - b1 * s1) * sc, o20 = (a0 * s0 + b0 * c0) * sc, o21 = (a1 * s1 + b1 * c1) * sc;
                    bf16* p = dst + (size_t)row * QKW + head * 128 + dd0;
                    *(v4u*)p = pack8(o10, o11); *(v4u*)(p + 64) = pack8(o20, o21);
                    if (m & 1) asm volatile("" ::: "memory");
                }
        } else if (u.pn < 8) {
            const int col0 = (u.pn - 4) * 256 + wc * 32 + 8 * fq;
#pragma unroll
            for (int ai = 0; ai < 2; ++ai)
#pragma unroll
                for (int m = 0; m < 4; ++m)
#pragma unroll
                    for (int bj = 0; bj < 2; ++bj) {
                        f32x4 v[2];
#pragma unroll
                        for (int n = 0; n < 2; ++n)
#pragma unroll
                            for (int j = 0; j < 4; ++j) { const float a = acc[ai][bj][m][n][j]; v[n][j] = a * __builtin_amdgcn_rcpf(1.0f + __expf(-a)); }
                        *(v4u*)(SG + (size_t)(row0 + ai * 128 + m * 16) * VW + col0 + bj * 128) = pack8(v[0], v[1]);
                    }
        } else if (u.pn < 10) {
            const int col0 = (u.pn - 8) * 256 + wc * 32 + 8 * fq;
#pragma unroll
            for (int ai = 0; ai < 2; ++ai)
#pragma unroll
                for (int m = 0; m < 4; ++m)
#pragma unroll
                    for (int bj = 0; bj < 2; ++bj) *(v4u*)(PU + (size_t)(row0 + ai * 128 + m * 16) * PW + col0 + bj * 128) = pack8(acc[ai][bj][m][0], acc[ai][bj][m][1]);
        } else {
            const int col0 = (u.pn - 10) * 256 + wc * 32 + 8 * fq;
            f32x4 bv[2][2];
#pragma unroll
            for (int bj = 0; bj < 2; ++bj)
#pragma unroll
                for (int n = 0; n < 2; ++n) bv[bj][n] = *(const f32x4*)(bgate + col0 + bj * 128 + 4 * n);
#pragma unroll
            for (int ai = 0; ai < 2; ++ai)
#pragma unroll
                for (int m = 0; m < 4; ++m)
#pragma unroll
                    for (int bj = 0; bj < 2; ++bj) {
                        f32x4 v[2];
#pragma unroll
                        for (int n = 0; n < 2; ++n)
#pragma unroll
                            for (int j = 0; j < 4; ++j) { const float a = acc[ai][bj][m][n][j] + bv[bj][n][j]; v[n][j] = __builtin_amdgcn_rcpf(1.0f + __expf(-a)); }
                        *(v4u*)(GT + (size_t)(row0 + ai * 128 + m * 16) * 2048 + col0 + bj * 128) = pack8(v[0], v[1]);
                    }
        }
    }
};
struct EpiInT {
    static constexpr bool PERM = true; static constexpr int MID_T = 0;
    unsigned char* ws;
    __device__ __forceinline__ void operator()(const f32x4 (&acc)[2][2][4][2], const pg8::Unit& u, int wr, int wc, int fr, int fq) const {
        const int tok0 = u.pn * 256 + wc * 32 + 8 * fq;
        if (u.pm < 2) {
            GAS unsigned char* const KT = (GAS unsigned char*)(ws + WS_KT); const GAS unsigned char* const T2C = (const GAS unsigned char*)(ws + WS_T2C); const GAS unsigned char* const T2S = (const GAS unsigned char*)(ws + WS_T2S);
            const int head = 2 * u.pm + wr;
#pragma unroll
            for (int m = 0; m < 4; ++m) {
                const int dd = 16 * m + fr;
#pragma unroll
                for (int bj = 0; bj < 2; ++bj) {
                    const int tok = tok0 + bj * 128, pos = tok & (SEQ - 1);
                    const unsigned toff = (unsigned)(dd * SEQ + pos) * 4u;
                    const f32x4 c0 = *(const GAS f32x4*)(T2C + toff), c1 = *(const GAS f32x4*)(T2C + toff + 16), s0 = *(const GAS f32x4*)(T2S + toff), s1 = *(const GAS f32x4*)(T2S + toff + 16);
                    const f32x4 a0 = acc[0][bj][m][0], a1 = acc[0][bj][m][1], b0 = acc[1][bj][m][0], b1 = acc[1][bj][m][1];
                    const unsigned koff = (unsigned)((head * 128 + dd) * MTOK + tok) * 2u;
                    *(GAS v4u*)(KT + koff) = pack8(a0 * c0 - b0 * s0, a1 * c1 - b1 * s1);
                    *(GAS v4u*)(KT + koff + (unsigned)(64 * MTOK * 2)) = pack8(a0 * s0 + b0 * c0, a1 * s1 + b1 * c1);
                    asm volatile("" ::: "memory");
                }
            }
        } else {
            GAS unsigned char* const VS = (GAS unsigned char*)(ws + WS_VS); const GAS float* const DEC = (const GAS float*)(ws + WS_DEC);
            const int head = u.pm - 2; const GAS float* d = DEC + head * 128 + wc * 32 + 8 * fq;
            const f32x4 d0 = *(const GAS f32x4*)d, d1 = *(const GAS f32x4*)(d + 4);
#pragma unroll
            for (int ai = 0; ai < 2; ++ai)
#pragma unroll
                for (int m = 0; m < 4; ++m) {
#pragma unroll
                    for (int bj = 0; bj < 2; ++bj)
                        *(GAS v4u*)(VS + (unsigned)((head * 256 + ai * 128 + wr * 64 + m * 16 + fr) * MTOK + tok0 + bj * 128) * 2u) = pack8(acc[ai][bj][m][0] * d0, acc[ai][bj][m][1] * d1);
                    asm volatile("" ::: "memory");
                }
        }
    }
};

__device__ __forceinline__ void p2_scan_pool(Frame& F, const __attribute__((address_space(4))) Args* Ap) {
    const __attribute__((address_space(4))) Args& A = *Ap;
    const bf16* KT = (const bf16*)(F.ws + WS_KT); const bf16* VS = (const bf16*)(F.ws + WS_VS); bf16* ST = (bf16*)(F.ws + WS_ST);
    const int gw = F.vcu * NWAVES + F.wave, NGW = F.G * NWAVES; const int r = F.lane & 15, q = F.lane >> 4;
    for (int item = gw; item < 2048; item += NGW) {
        const int bh = item >> 6, es = (item >> 2) & 15, ds = item & 3, b = bh >> 2, h = bh & 3, e0 = 16 * es, d0 = 32 * ds;
        const bf16* ka = KT + (size_t)(h * 128 + d0 + r) * MTOK + b * SEQ + 8 * q;
        const bf16* vb = VS + (size_t)(h * 256 + e0 + r) * MTOK + b * SEQ + 8 * q;
        const float g1 = A.g1[h], g127 = A.g127[h], g128 = A.g128[h];
        f32x4 s0 = {0.f, 0.f, 0.f, 0.f}, s1 = {0.f, 0.f, 0.f, 0.f};
        bf16x8 a0[4], a1[4], bb[4];
#pragma unroll
        for (int ks = 0; ks < 4; ++ks) { a0[ks] = *(const bf16x8*)(ka + 32 * ks); a1[ks] = *(const bf16x8*)(ka + (size_t)16 * MTOK + 32 * ks); bb[ks] = *(const bf16x8*)(vb + 32 * ks); }
        for (int n = 0; n < NCH; ++n) {
            bf16* sp = ST + ((size_t)(((b * NCH + n) * NH + h) * 256 + e0 + r)) * 128 + d0 + 4 * q;
            { v2u w; w.x = cvt_pk_bf16(s0[0] * g1, s0[1] * g1); w.y = cvt_pk_bf16(s0[2] * g1, s0[3] * g1); *(v2u*)sp = w;
              w.x = cvt_pk_bf16(s1[0] * g1, s1[1] * g1); w.y = cvt_pk_bf16(s1[2] * g1, s1[3] * g1); *(v2u*)(sp + 16) = w; }
            if (n == NCH - 1) break;
            bf16x8 na0[4], na1[4], nb[4];
            const int nn = (n + 1 < NCH - 1) ? n + 1 : n;
#pragma unroll
            for (int ks = 0; ks < 4; ++ks) { na0[ks] = *(const bf16x8*)(ka + nn * CHUNK + 32 * ks); na1[ks] = *(const bf16x8*)(ka + (size_t)16 * MTOK + nn * CHUNK + 32 * ks); nb[ks] = *(const bf16x8*)(vb + nn * CHUNK + 32 * ks); }
            f32x4 c0 = {0.f, 0.f, 0.f, 0.f}, c1 = {0.f, 0.f, 0.f, 0.f};
#pragma unroll
            for (int ks = 0; ks < 4; ++ks) { c0 = __builtin_amdgcn_mfma_f32_16x16x32_bf16(a0[ks], bb[ks], c0, 0, 0, 0); c1 = __builtin_amdgcn_mfma_f32_16x16x32_bf16(a1[ks], bb[ks], c1, 0, 0, 0); }
            s0 = s0 * g128 + c0 * g127; s1 = s1 * g128 + c1 * g127;
#pragma unroll
            for (int ks = 0; ks < 4; ++ks) { a0[ks] = na0[ks]; a1[ks] = na1[ks]; bb[ks] = nb[ks]; }
        }
    }
    const bf16* PU = (const bf16*)(F.ws + WS_PU); bf16* RGP = (bf16*)F.out;
    const int gt = F.vcu * NWAVES * 64 + F.tid, NGT = F.G * NWAVES * 64;
    for (int i = gt; i < MTOK * 64; i += NGT) {
        const int t = i >> 6, cg = i & 63, col0 = 8 * cg, w = 2 << (col0 >> 7), pos = t & (SEQ - 1), cnt = (pos + 1 < w) ? pos + 1 : w;
        float s[8];
#pragma unroll
        for (int k = 0; k < 8; ++k) s[k] = 0.f;
        v4u u0 = *(const v4u*)(PU + (size_t)t * PW + col0);
        for (int j = 0; j < cnt; ++j) { const v4u v = *(const v4u*)(PU + (size_t)(t - j) * PW + col0);
            s[0] += bf_lo(v.x); s[1] += bf_hi(v.x); s[2] += bf_lo(v.y); s[3] += bf_hi(v.y); s[4] += bf_lo(v.z); s[5] += bf_hi(v.z); s[6] += bf_lo(v.w); s[7] += bf_hi(v.w); }
        const float ic = 1.0f / (float)cnt;
        v4u o; o.x = pk2(s[0] * ic - bf_lo(u0.x), s[1] * ic - bf_hi(u0.x)); o.y = pk2(s[2] * ic - bf_lo(u0.y), s[3] * ic - bf_hi(u0.y));
        o.z = pk2(s[4] * ic - bf_lo(u0.z), s[5] * ic - bf_hi(u0.z)); o.w = pk2(s[6] * ic - bf_lo(u0.w), s[7] * ic - bf_hi(u0.w));
        *(v4u*)(RGP + (size_t)t * RPITCH + 1024 + col0) = o;
    }
}

__device__ __forceinline__ void p3_retention(Frame& F, const __attribute__((address_space(4))) Args* Ap) {
    const __attribute__((address_space(4))) Args& A = *Ap;
    const bf16* Q = (const bf16*)(F.ws + WS_Q); const bf16* Kb = (const bf16*)(F.ws + WS_K); const bf16* VS = (const bf16*)(F.ws + WS_VS); const bf16* ST = (const bf16*)(F.ws + WS_ST);
    const bf16* SG = (const bf16*)(F.ws + WS_SG); bf16* RGP = (bf16*)F.out;
    const int r = F.lane & 15, q = F.lane >> 4;
    for (int unit = F.vcu; unit < BATCH * NCH * NH; unit += F.G) {
        const int h = unit & 3, n = (unit >> 2) & 31, b = unit >> 7, w = F.wave;
        const int tok0 = b * SEQ + n * CHUNK, cl = 16 * w + r, nks = ((16 * w + 15) >> 5) + 1;
        bf16x8 qf[4];
#pragma unroll
        for (int ks = 0; ks < 4; ++ks) qf[ks] = *(const bf16x8*)(Q + (size_t)(tok0 + cl) * QKW + h * 128 + 32 * ks + 8 * q);
        bf16x8 pf[4];
#pragma unroll
        for (int k2 = 0; k2 < 4; ++k2) {
            v4u pw = {0u, 0u, 0u, 0u};
            if (k2 < nks) {
                f32x4 sa = {0.f, 0.f, 0.f, 0.f}, sb = {0.f, 0.f, 0.f, 0.f};
                const bf16* k0p = Kb + (size_t)(tok0 + 32 * k2 + 8 * (r >> 2) + (r & 3)) * QKW + h * 128 + 8 * q;
#pragma unroll
                for (int ks = 0; ks < 4; ++ks) {
                    const bf16x8 ka = *(const bf16x8*)(k0p + 32 * ks), kb = *(const bf16x8*)(k0p + 4 * QKW + 32 * ks);
                    sa = __builtin_amdgcn_mfma_f32_16x16x32_bf16(ka, qf[ks], sa, 0, 0, 0); sb = __builtin_amdgcn_mfma_f32_16x16x32_bf16(kb, qf[ks], sb, 0, 0, 0);
                }
                const int mb = 32 * k2 + 8 * q;
#pragma unroll
                for (int i = 0; i < 4; ++i) { if (mb + i > cl) sa[i] = 0.f; if (mb + 4 + i > cl) sb[i] = 0.f; }
                pw.x = cvt_pk_bf16(sa[0], sa[1]); pw.y = cvt_pk_bf16(sa[2], sa[3]); pw.z = cvt_pk_bf16(sb[0], sb[1]); pw.w = cvt_pk_bf16(sb[2], sb[3]);
            }
            pf[k2] = __builtin_bit_cast(bf16x8, pw);
        }
        f32x4 acc[16];
#pragma unroll
        for (int g = 0; g < 16; ++g) acc[g] = (f32x4){0.f, 0.f, 0.f, 0.f};
        const bf16* vp = VS + (size_t)(h * 256 + r) * MTOK + tok0 + 8 * q;
#pragma unroll
        for (int ks = 0; ks < 4; ++ks) {
            if (ks < nks) {
#pragma unroll
                for (int g = 0; g < 16; ++g) { const bf16x8 vf = *(const bf16x8*)(vp + (size_t)(16 * g) * MTOK + 32 * ks); acc[g] = __builtin_amdgcn_mfma_f32_16x16x32_bf16(vf, pf[ks], acc[g], 0, 0, 0); }
            }
        }
        const bf16* sp = ST + ((size_t)(((b * NCH + n) * NH + h) * 256 + r)) * 128 + 8 * q;
#pragma unroll
        for (int ks = 0; ks < 4; ++ks)
#pragma unroll
            for (int g = 0; g < 16; ++g) { const bf16x8 sf = *(const bf16x8*)(sp + (size_t)(16 * g) * 128 + 32 * ks); acc[g] = __builtin_amdgcn_mfma_f32_16x16x32_bf16(sf, qf[ks], acc[g], 0, 0, 0); }
        const float rs = __expf((float)cl * A.lg[h]);
        float s = 0.f;
#pragma unroll
        for (int g = 0; g < 16; ++g) { acc[g] = acc[g] * rs; s += (acc[g][0] + acc[g][1]) + (acc[g][2] + acc[g][3]); }
        s += __shfl_xor(s, 16); s += __shfl_xor(s, 32);
        const float mu = s * (1.0f / 256.0f); float v = 0.f;
#pragma unroll
        for (int g = 0; g < 16; ++g) { acc[g] = acc[g] - mu; v += (acc[g][0] * acc[g][0] + acc[g][1] * acc[g][1]) + (acc[g][2] * acc[g][2] + acc[g][3] * acc[g][3]); }
        v += __shfl_xor(v, 16); v += __shfl_xor(v, 32);
        const float rstd = 1.0f / sqrtf(v * (1.0f / 256.0f) + EPS);
        const bf16* gp = SG + (size_t)(tok0 + cl) * VW + h * 256 + 4 * q; bf16* op = RGP + (size_t)(tok0 + cl) * RPITCH + h * 256 + 4 * q;
#pragma unroll
        for (int g = 0; g < 16; ++g) {
            const v2u gv = *(const v2u*)(gp + 16 * g);
            v2u o; o.x = cvt_pk_bf16(acc[g][0] * rstd * bf_lo(gv.x), acc[g][1] * rstd * bf_hi(gv.x)); o.y = cvt_pk_bf16(acc[g][2] * rstd * bf_lo(gv.y), acc[g][3] * rstd * bf_hi(gv.y));
            *(v2u*)(op + 16 * g) = o;
        }
    }
}

struct EpiMix {
    static constexpr bool PERM = true; static constexpr int MID_T = 16;
    unsigned char* ws;
    __device__ __forceinline__ void mid(f32x4 (&acc)[2][2][4][2], const pg8::Unit& u, int wr, int wc, int fr, int fq) const {
        const int row0 = u.pm * 256 + wr * 64 + fr, col0 = u.pn * 256 + wc * 32 + 8 * fq;
        const GAS unsigned char* gbase = (const GAS unsigned char*)(ws + WS_GT);
        unsigned goff = (unsigned)(row0 * 2048 + col0) * 2u;
#pragma unroll
        for (int ai = 0; ai < 2; ++ai)
#pragma unroll
            for (int m = 0; m < 4; ++m) {
                asm volatile("" : "+v"(goff));
#pragma unroll
                for (int bj = 0; bj < 2; ++bj) {
                    const GAS unsigned char* gp = gbase + (goff + (unsigned)((ai * 128 + m * 16) * 4096 + bj * 256));
                    const v4u ga = *(const GAS v4u*)gp, gb = *(const GAS v4u*)(gp + 2048);
                    f32x4 r0, r1;
                    r0[0] = bf_lo(ga.x) * __builtin_amdgcn_rcpf(bf_lo(gb.x)); r0[1] = bf_hi(ga.x) * __builtin_amdgcn_rcpf(bf_hi(gb.x)); r0[2] = bf_lo(ga.y) * __builtin_amdgcn_rcpf(bf_lo(gb.y)); r0[3] = bf_hi(ga.y) * __builtin_amdgcn_rcpf(bf_hi(gb.y));
                    r1[0] = bf_lo(ga.z) * __builtin_amdgcn_rcpf(bf_lo(gb.z)); r1[1] = bf_hi(ga.z) * __builtin_amdgcn_rcpf(bf_hi(gb.z)); r1[2] = bf_lo(ga.w) * __builtin_amdgcn_rcpf(bf_lo(gb.w)); r1[3] = bf_hi(ga.w) * __builtin_amdgcn_rcpf(bf_hi(gb.w));
                    acc[ai][bj][m][0] = acc[ai][bj][m][0] * r0; acc[ai][bj][m][1] = acc[ai][bj][m][1] * r1;
                }
                asm volatile("" ::: "memory");
            }
    }
    __device__ __forceinline__ void operator()(const f32x4 (&acc)[2][2][4][2], const pg8::Unit& u, int wr, int wc, int fr, int fq) const {
        const int row0 = u.pm * 256 + wr * 64 + fr, col0 = u.pn * 256 + wc * 32 + 8 * fq;
        const bf16* const GT = (const bf16*)(ws + WS_GT); bf16* const MIX = (bf16*)(ws + WS_MIX);
#pragma unroll
        for (int ai = 0; ai < 2; ++ai)
#pragma unroll
            for (int m = 0; m < 4; ++m)
#pragma unroll
                for (int bj = 0; bj < 2; ++bj) {
                    const size_t row = (size_t)(row0 + ai * 128 + m * 16);
                    const v4u gb = *(const v4u*)(GT + row * 2048 + 1024 + col0 + bj * 128);
                    const f32x4 g0 = {bf_lo(gb.x), bf_hi(gb.x), bf_lo(gb.y), bf_hi(gb.y)}, g1 = {bf_lo(gb.z), bf_hi(gb.z), bf_lo(gb.w), bf_hi(gb.w)};
                    *(v4u*)(MIX + row * DM + col0 + bj * 128) = pack8(acc[ai][bj][m][0] * g0, acc[ai][bj][m][1] * g1);
                }
    }
};
template <bool WITH_B16> struct EpiRes {
    static constexpr bool PERM = false; static constexpr int MID_T = 0;
    unsigned char* ws; const float* xin; float* dout;
    __device__ __forceinline__ void operator()(const f32x4 (&acc)[2][2][4][2], const pg8::Unit& u, int wr, int wc, int fr, int fq) const {
        const int row0 = u.pm * 256 + wr * 64 + fr, col0 = u.pn * 256 + wc * 32 + 4 * fq;
        const float* const base = WITH_B16 ? xin : (const float*)(ws + WS_X1); float* const out = WITH_B16 ? (float*)(ws + WS_X1) : dout; bf16* const ob = (bf16*)(ws + WS_X1B); float* const ss = (float*)(ws + (WITH_B16 ? WS_SS2 : WS_SS3));
#pragma unroll
        for (int ai = 0; ai < 2; ++ai)
#pragma unroll
            for (int m = 0; m < 4; ++m) {
                const int row = row0 + ai * 128 + m * 16; const size_t off = (size_t)row * DM + col0; float s = 0.f;
#pragma unroll
                for (int bj = 0; bj < 2; ++bj)
#pragma unroll
                    for (int n = 0; n < 2; ++n) {
                        const f32x4 o = *(const f32x4*)(base + off + bj * 128 + n * 16) + acc[ai][bj][m][n];
                        *(f32x4*)(out + off + bj * 128 + n * 16) = o; s += (o[0] * o[0] + o[1] * o[1]) + (o[2] * o[2] + o[3] * o[3]);
                        if (WITH_B16) { v2u w; w.x = cvt_pk_bf16(o[0], o[1]); w.y = cvt_pk_bf16(o[2], o[3]); *(v2u*)(ob + off + bj * 128 + n * 16) = w; }
                    }
                s += __shfl_xor(s, 16); s += __shfl_xor(s, 32);
                if (fq == 0) atomicAdd(ss + row, s);
                if (m & 1) asm volatile("" ::: "memory");
            }
    }
};
struct EpiUp {
    static constexpr bool PERM = true; static constexpr int MID_T = 0;
    unsigned char* ws;
    __device__ __forceinline__ void operator()(const f32x4 (&acc)[2][2][4][2], const pg8::Unit& u, int wr, int wc, int fr, int fq) const {
        const int row0 = u.pm * 256 + wr * 64 + fr, col0 = u.pn * 256 + wc * 32 + 8 * fq;
        const float* const ss = (const float*)(ws + WS_SS2); bf16* const HID = (bf16*)(ws + WS_HID);
#pragma unroll
        for (int ai = 0; ai < 2; ++ai)
#pragma unroll
            for (int m = 0; m < 4; ++m) {
                const int row = row0 + ai * 128 + m * 16; const float rstd = 1.0f / sqrtf(ss[row] * (1.0f / DM) + EPS);
#pragma unroll
                for (int bj = 0; bj < 2; ++bj) {
                    f32x4 v[2];
#pragma unroll
                    for (int n = 0; n < 2; ++n)
#pragma unroll
                        for (int j = 0; j < 4; ++j) { const float a = fmaxf(acc[ai][bj][m][n][j] * rstd, 0.f); v[n][j] = a * a; }
                    *(v4u*)(HID + (size_t)row * DFF + col0 + bj * 128) = pack8(v[0], v[1]);
                }
            }
    }
};

typedef const __attribute__((address_space(4))) Args* KArgs;
#define KARGS() ({ KArgs p_ = (KArgs)__builtin_amdgcn_kernarg_segment_ptr(); asm volatile("" : "+s"(p_)); p_; })
__device__ __forceinline__ void frame_init(Frame& F, KArgs ap) {
    extern __shared__ __attribute__((aligned(16))) unsigned char lds[];
    F.lds = (LAS unsigned char*)lds;
    int t_ = threadIdx.x; asm volatile("" : "+v"(t_));
    F.tid = t_; F.lane = t_ & 63; F.wave = __builtin_amdgcn_readfirstlane(t_ >> 6);
    F.G = gridDim.x; { const int bx = blockIdx.x; F.vcu = (F.G % 8 == 0) ? (bx % 8) * (F.G / 8) + bx / 8 : bx; }
    F.ws = ap->ws; F.out = ap->out; F.ctl = (gu32*)(F.ws + WS_CTL);
}
__global__ void __launch_bounds__(NWAVES * 64, 2) skel_fwd(Args args_unused) {
    extern __shared__ __attribute__((aligned(16))) unsigned char lds[];
    {
        LAS unsigned char* L = (LAS unsigned char*)lds;
        for (int u = threadIdx.x; u < (LDS_BYTES - LDSCTL_OFF) / 4; u += NWAVES * 64) ((LAS unsigned*)(L + LDSCTL_OFF))[u] = 0u;
        __syncthreads();
        KArgs ap = KARGS();
        if (N_LAUNCHES == 1 && threadIdx.x == 0) (void)xb_add((unsigned*)(ap->ws + WS_CTL) + CW_BAR + XB_XCNT(xb_xcc_id()), 1u);
    }
#ifdef DBG_STOP
#define IN(k) ({ KArgs q_ = KARGS(); ((k) <= DBG_STOP && q_->ph_lo <= (k) && (k) < q_->ph_hi); })
#else
#define IN(k) ({ KArgs q_ = KARGS(); (q_->ph_lo <= (k) && (k) < q_->ph_hi); })
#endif
#define SEAM(k) do { if (N_LAUNCHES == 1) { KArgs q_ = KARGS(); if (q_->ph_lo <= (k) && (k) + 1 < q_->ph_hi) { XcdBarrier b_; b_.bar = (unsigned*)(q_->ws + WS_CTL) + CW_BAR; b_.x = xb_xcc_id(); \
        b_.st = (volatile LAS unsigned*)((LAS unsigned char*)lds + MISC_OFF) + 8; xcd_barrier(b_); } } } while (0)

    if (IN(0)) { KArgs ap = KARGS(); Frame F; frame_init(F, ap); p0_prologue(F, ap); } SEAM(0);

    if (IN(1)) {
        { KArgs ap = KARGS(); unsigned char* ws = ap->ws;
          pg8::Gemm g{(const bf16*)(ws + WS_XN), (const bf16*)(ws + WS_BT1), MTOK, N1, DM}; pg8::StaticOrder<MTOK, N1> S; S.init((int)gridDim.x, (int)blockIdx.x);
          EpiIn E{ws, ap->in[3]};
          pg8::gemm_phase<EpiIn, pg8::StaticOrder<MTOK, N1>, DM, PG8_ALIGN, PG8_SP2>((LAS unsigned char*)lds + RING_OFF, g, S, E); }
        { KArgs ap = KARGS(); unsigned char* ws = ap->ws;
          pg8::Gemm g{(const bf16*)(ws + WS_WT2), (const bf16*)(ws + WS_XN), M2, MTOK, DM}; pg8::StaticOrder<M2, MTOK> S; S.init((int)gridDim.x, (int)blockIdx.x);
          EpiInT E{ws};
          pg8::gemm_phase<EpiInT, pg8::StaticOrder<M2, MTOK>, DM, PG8_ALIGN, PG8_SP2>((LAS unsigned char*)lds + RING_OFF, g, S, E); }
    } SEAM(1);

    if (IN(2)) { KArgs ap = KARGS(); Frame F; frame_init(F, ap); p2_scan_pool(F, ap); } SEAM(2);

    if (IN(3)) { KArgs ap = KARGS(); Frame F; frame_init(F, ap); p3_retention(F, ap); } SEAM(3);

    if (IN(4)) {
        KArgs ap = KARGS(); unsigned char* ws = ap->ws;
        pg8::Gemm g{(const bf16*)ap->out, (const bf16*)(ws + WS_BT4), MTOK, DM, K4}; pg8::StaticOrder<MTOK, DM> S; S.init((int)gridDim.x, (int)blockIdx.x);
        EpiMix E{ws};
        pg8::gemm_phase<EpiMix, pg8::StaticOrder<MTOK, DM>, K4, PG8_ALIGN, PG8_SP2>((LAS unsigned char*)lds + RING_OFF, g, S, E);
    } SEAM(4);

    if (IN(5)) {
        KArgs ap = KARGS(); unsigned char* ws = ap->ws;
        pg8::Gemm g{(const bf16*)(ws + WS_MIX), (const bf16*)(ws + WS_BT5), MTOK, DM, DM}; pg8::StaticOrder<MTOK, DM> S; S.init((int)gridDim.x, (int)blockIdx.x);
        EpiRes<true> E{ws, ap->in[0], nullptr};
        pg8::gemm_phase<EpiRes<true>, pg8::StaticOrder<MTOK, DM>, DM, PG8_ALIGN, PG8_SP2>((LAS unsigned char*)lds + RING_OFF, g, S, E);
    } SEAM(5);

    if (IN(6)) {
        KArgs ap = KARGS(); unsigned char* ws = ap->ws;
        pg8::Gemm g{(const bf16*)(ws + WS_X1B), (const bf16*)(ws + WS_BT6), MTOK, DFF, DM}; pg8::StaticOrder<MTOK, DFF> S; S.init((int)gridDim.x, (int)blockIdx.x);
        EpiUp E{ws};
        pg8::gemm_phase<EpiUp, pg8::StaticOrder<MTOK, DFF>, DM, PG8_ALIGN, PG8_SP2>((LAS unsigned char*)lds + RING_OFF, g, S, E);
    } SEAM(6);

    if (IN(7)) {
        KArgs ap = KARGS(); unsigned char* ws = ap->ws;
        pg8::Gemm g{(const bf16*)(ws + WS_HID), (const bf16*)(ws + WS_BT7), MTOK, DM, DFF}; pg8::StaticOrder<MTOK, DM> S; S.init((int)gridDim.x, (int)blockIdx.x);
        EpiRes<false> E{ws, nullptr, ap->out};
        pg8::gemm_phase<EpiRes<false>, pg8::StaticOrder<MTOK, DM>, DFF, PG8_ALIGN, PG8_SP2>((LAS unsigned char*)lds + RING_OFF, g, S, E);
    } SEAM(7);

    if (IN(8)) {
        KArgs ap = KARGS(); Frame F; frame_init(F, ap);
        const float* lnf = ap->in[13]; const float* ss = (const float*)(F.ws + WS_SS3); float* outp = F.out;
        const int gw = F.vcu * NWAVES + F.wave, NGW = F.G * NWAVES;
        unsigned bad = (N_LAUNCHES == 1) ? (xb_ld((unsigned*)(F.ctl + CW_BAR) + XB_TMO) != 0u) : 0u;
        const float qn = __builtin_nanf("");
        f32x4 gv[4];
#pragma unroll
        for (int j = 0; j < 4; ++j) gv[j] = ((const GAS f32x4*)lnf)[64 * j + F.lane];
        for (int m = gw; m < MTOK; m += NGW) {
            GAS f32x4* o = (GAS f32x4*)(outp + (size_t)m * DM) + F.lane; const float rstd = 1.0f / sqrtf(ss[m] * (1.0f / DM) + EPS);
#pragma unroll
            for (int j = 0; j < 4; ++j) { f32x4 v = o[64 * j] * rstd * gv[j]; if (bad) v = (f32x4){qn, qn, qn, qn}; o[64 * j] = v; }
        }
    }
#ifdef DBG_STOP
    {
        KArgs ap = KARGS();
        if (ap->ph_hi == N_PHASES) {
            Frame F; frame_init(F, ap); const unsigned char* ws = F.ws; float* outp = F.out;
            const int gt = F.vcu * NWAVES * 64 + F.tid, NGT = F.G * NWAVES * 64;
            const size_t M16 = (size_t)1 << 24;
            for (size_t i = (DBG_STOP == 2 || DBG_STOP == 3) ? (size_t)gt + 25165824 : (size_t)gt; i < (size_t)MTOK * DM; i += NGT) {
                float v = 0.f;
#define BF(off, cnt) bf_lo((unsigned)((const bf16*)(ws + (off)))[i % (cnt)])
                if (DBG_STOP == 0) { v = BF(WS_XN, 2 * M16) + BF(WS_BT1, 4608 * 1024) + BF(WS_WT2, 1536 * 1024) + BF(WS_BT4, 1536 * 1024) + BF(WS_BT5, 1024 * 1024) + BF(WS_BT6, 4096 * 1024) + BF(WS_BT7, 4096 * 1024)
                                       + ((const float*)(ws + WS_T1))[i % (4096 * 128)] + ((const float*)(ws + WS_T2C))[i % (4096 * 64)] + ((const float*)(ws + WS_T2S))[i % (4096 * 64)] + ((const float*)(ws + WS_DEC))[i % 512]; }
                if (DBG_STOP == 1) { v = BF(WS_Q, M16) + BF(WS_K, M16) + BF(WS_KT, M16) + BF(WS_VS, 2 * M16) + BF(WS_SG, 2 * M16) + BF(WS_PU, M16) + BF(WS_GT, 4 * M16); }
                if (DBG_STOP == 2 || DBG_STOP == 3) { v = BF(WS_ST, 2 * M16); }
                if (DBG_STOP == 4) { v = BF(WS_MIX, 2 * M16); }
                if (DBG_STOP == 5) { v = BF(WS_X1B, 2 * M16) + ((const float*)(ws + WS_SS2))[i % MTOK]; }
                if (DBG_STOP == 6) { v = BF(WS_HID, 8 * M16); }
                outp[i] = v;
            }
        }
    }
#endif
#undef IN
#undef SEAM
}

extern "C" void kernel_launch(void* const* d_in, const int* in_sizes, int n_in, void* d_out, int out_size, void* d_ws, size_t ws_size, hipStream_t stream) {
    static int grid = 0;
    if (grid == 0) {
        if (n_in != 14 || in_sizes[0] != MTOK * DM || out_size != MTOK * DM || ws_size < WS_END) { fprintf(stderr, "kernel_launch: unexpected shapes (n_in %d, in0 %d, out %d, ws %zu); nothing launched\n", n_in, n_in > 0 ? in_sizes[0] : -1, out_size, ws_size); grid = -1; return; }
        int dev = 0, cus = 0, per_cu = 0;
        if (hipGetDevice(&dev) != hipSuccess || hipDeviceGetAttribute(&cus, hipDeviceAttributeMultiprocessorCount, dev) != hipSuccess) { fprintf(stderr, "kernel_launch: device query failed\n"); grid = -1; return; }
        if (hipFuncSetAttribute((const void*)skel_fwd, hipFuncAttributeMaxDynamicSharedMemorySize, LDS_BYTES) != hipSuccess) { fprintf(stderr, "kernel_launch: hipFuncSetAttribute failed\n"); grid = -1; return; }
        if (hipOccupancyMaxActiveBlocksPerMultiprocessor(&per_cu, (const void*)skel_fwd, NWAVES * 64, LDS_BYTES) != hipSuccess || per_cu < 1) fprintf(stderr, "kernel_launch: occupancy query reports %d workgroups per CU\n", per_cu);
        (void)hipGetLastError();
        grid = cus;
    }
    if (grid < 0) return;
    (void)hipMemsetAsync((char*)d_ws + WS_CTL, 0, CTL_ZERO_BYTES, stream);
    Args a{};
    for (int i = 0; i < 14; ++i) a.in[i] = (const float*)d_in[i];
    a.out = (float*)d_out; a.ws = (unsigned char*)d_ws;
    for (int d = 0; d < 64; ++d) a.invf[d] = std::pow(10000.0, -(double)d / 64.0);
    for (int h = 0; h < 4; ++h) { const double gam = 1.0 - std::exp2(-5.0 - h), lgm = std::log(gam); a.lg[h] = (float)lgm; a.g1[h] = (float)gam; a.g127[h] = (float)std::exp(127.0 * lgm); a.g128[h] = (float)std::exp(128.0 * lgm); }
    if (N_LAUNCHES == 1) { a.ph_lo = 0; a.ph_hi = N_PHASES; hipLaunchKernelGGL(skel_fwd, dim3(grid), dim3(NWAVES * 64), LDS_BYTES, stream, a); }
    else for (int p = 0; p < N_PHASES; ++p) { a.ph_lo = p; a.ph_hi = p + 1; hipLaunchKernelGGL(skel_fwd, dim3(grid), dim3(NWAVES * 64), LDS_BYTES, stream, a); }
}
```

```cpp
#include <hip/hip_runtime.h>
#include <cstdio>
#include <cstdint>
#include <cmath>

#ifndef MK_N_LAUNCHES
#define MK_N_LAUNCHES 1
#endif
constexpr int N_PHASES = 9;
constexpr int N_LAUNCHES = MK_N_LAUNCHES;
static_assert(N_LAUNCHES == 1 || N_LAUNCHES == N_PHASES, "MK_N_LAUNCHES is 1 or 9");

namespace pg8 {
#define PG8_LAS __attribute__((address_space(3)))
typedef unsigned short bf16_t;
typedef short bf16x8 __attribute__((ext_vector_type(8)));
typedef float f32x4 __attribute__((ext_vector_type(4)));
typedef unsigned u32x4 __attribute__((ext_vector_type(4)));
typedef unsigned u32x2 __attribute__((ext_vector_type(2)));
constexpr int BM = 256, BK = 64, HALF = 128, HTB = HALF * BK * 2, STAGE_BYTES = 8 * HTB, NXCD = 8, WGM = 8;

__host__ __device__ __forceinline__ int lds_byte(int r, int c) { const int st = (r >> 4) * 2 + (c >> 5), rr = r & 15, cc = c & 31, ob = rr * 64 + cc * 2; return st * 1024 + (ob ^ (((ob >> 9) & 1) << 5)); }
__host__ __device__ __forceinline__ void stage_rc(int b, int& R, int& C) { const int st = b / 1024, sb = b % 1024, swz = sb ^ (((sb >> 9) & 1) << 5); R = (st >> 1) * 16 + swz / 64; C = (st & 1) * 32 + (swz % 64) / 2; }
__host__ __device__ __forceinline__ int perm32(int rho) { const int n = rho >> 4, i = rho & 15; return 8 * (i >> 2) + 4 * n + (i & 3); }

struct Unit { int pm, pn; };
struct Gemm { const bf16_t* A; const bf16_t* Bt; int M, N, K; };

template <int M_, int N_> struct StaticOrder {
    static constexpr int nM = M_ / BM, nN = N_ / BM, nwg = nM * nN;
    int G, c;
    __host__ __device__ void init(int G_, int c_) { G = G_; c = c_; }
    __host__ __device__ bool next(int i, Unit& u) const {
        const long L = (long)i * G + c; if (L >= nwg) return false;
        int wgid = (int)L; { const int q = nwg / NXCD, r = nwg % NXCD, xcd = wgid % NXCD, off = wgid / NXCD; wgid = (xcd < r ? xcd * (q + 1) : r * (q + 1) + (xcd - r) * q) + off; }
        static_assert(nM % WGM == 0 || nM < WGM, "row-tile groups are all the same size");
        constexpr int gsz = (nM < WGM) ? nM : WGM, nig = gsz * nN; const int gid = wgid / nig, fm = gid * gsz;
        u.pm = fm + ((wgid % nig) % gsz); u.pn = (wgid % nig) / gsz; return true;
    }
    __device__ __forceinline__ void a_ready(const Unit&) const {}
    __device__ __forceinline__ void done(const Unit&) const {}
};

typedef __bf16 bf16x2_t __attribute__((ext_vector_type(2)));
typedef float f32x2_t __attribute__((ext_vector_type(2)));
__device__ __forceinline__ unsigned cvt_pk_bf16(float lo, float hi) { const f32x2_t v = {lo, hi}; const bf16x2_t b = __builtin_convertvector(v, bf16x2_t); return __builtin_bit_cast(unsigned, b); }
__device__ __forceinline__ u32x4 pack8(const f32x4 a, const f32x4 b) { u32x4 w; w.x = cvt_pk_bf16(a[0], a[1]); w.y = cvt_pk_bf16(a[2], a[3]); w.z = cvt_pk_bf16(b[0], b[1]); w.w = cvt_pk_bf16(b[2], b[3]); return w; }
__device__ __forceinline__ float bf_lo(unsigned w) { return __uint_as_float(w << 16); }
__device__ __forceinline__ float bf_hi(unsigned w) { return __uint_as_float(w & 0xffff0000u); }

template <class Epi, class Sched, int K, bool ALIGN_EPI = false, bool SP2 = false>
__device__ __forceinline__ void gemm_phase(PG8_LAS unsigned char* lds, const Gemm g, const Sched& S, const Epi& E) {
    int tid = threadIdx.x; asm volatile("" : "+v"(tid));
    const int wid = __builtin_amdgcn_readfirstlane(tid >> 6), lane = tid & 63, wr = wid >> 2, wc = wid & 3, fr = lane & 15, fq = lane >> 4;
    constexpr int nt = K / BK;
    unsigned voffA[2], voffB[2];
#pragma unroll
    for (int i = 0; i < 2; ++i) { int R, C; stage_rc(tid * 16 + i * 8192, R, C); const int Rb = Epi::PERM ? ((R & ~31) + perm32(R & 31)) : R;
        voffA[i] = (unsigned)(R * K + C) * 2u; voffB[i] = (unsigned)(Rb * K + C) * 2u; }
    constexpr size_t kstep = (size_t)(BK * 2);
    constexpr size_t hstep = (size_t)HALF * K * 2;
    constexpr size_t tstep = 2 * hstep;
    const unsigned ldsw = (unsigned)wid * 1024u;
    const int aoff = lds_byte(wr * 64 + fr, fq * 8), boff = lds_byte(wc * 32 + fr, fq * 8);
#define PG8_SA(b, h) (((b) * 2 + (h)) * HTB)
#define PG8_SB(b, h) ((4 + (b) * 2 + (h)) * HTB)
#define PG8_STAGE(bufoff, gbase, voff) do { _Pragma("unroll") for (int _i = 0; _i < 2; ++_i) \
        __builtin_amdgcn_global_load_lds((const unsigned*)((const char*)(gbase) + (voff)[_i]), (PG8_LAS unsigned*)(lds + (bufoff) + ldsw + _i * 8192), 16, 0, 0); } while (0)
#define PG8_LDA(dst, b, h) do { _Pragma("unroll") for (int m = 0; m < 4; ++m) _Pragma("unroll") for (int k = 0; k < 2; ++k) dst[m][k] = *(const PG8_LAS bf16x8*)(lds + PG8_SA(b, h) + aoff + m * 2048 + k * 1024); } while (0)
#define PG8_LDB(dst, b, h) do { _Pragma("unroll") for (int n = 0; n < 2; ++n) _Pragma("unroll") for (int k = 0; k < 2; ++k) dst[n][k] = *(const PG8_LAS bf16x8*)(lds + PG8_SB(b, h) + boff + n * 2048 + k * 1024); } while (0)
#define PG8_MMA(ai, bj, At, Bt) do { __builtin_amdgcn_s_setprio(1); _Pragma("unroll") for (int m = 0; m < 4; ++m) _Pragma("unroll") for (int n = 0; n < 2; ++n) _Pragma("unroll") for (int k = 0; k < 2; ++k) \
        acc[ai][bj][m][n] = __builtin_amdgcn_mfma_f32_16x16x32_bf16(Bt[n][k], At[m][k], acc[ai][bj][m][n], 0, 0, 0); __builtin_amdgcn_s_setprio(0); } while (0)
#define PG8_WAIT_V(n) asm volatile("s_waitcnt vmcnt(" #n ")" ::: "memory")
#define PG8_WAIT_L(n) asm volatile("s_waitcnt lgkmcnt(" #n ")" ::: "memory")
#define PG8_BAR __builtin_amdgcn_s_barrier()
#define PG8_SCHED __builtin_amdgcn_sched_barrier(0)
    Unit cur, nxt; int ui = 0;
    if (!S.next(0, cur)) return;
    f32x4 acc[2][2][4][2];
#pragma unroll
    for (int a = 0; a < 2; ++a)
#pragma unroll
        for (int b = 0; b < 2; ++b)
#pragma unroll
            for (int m = 0; m < 4; ++m)
#pragma unroll
                for (int n = 0; n < 2; ++n) acc[a][b][m][n] = (f32x4){0.f, 0.f, 0.f, 0.f};
    bf16x8 At[4][2], B0[2][2], B1[2][2];
    const char* cA = (const char*)g.A + (size_t)cur.pm * tstep; const char* cB = (const char*)g.Bt + (size_t)cur.pn * tstep;
    S.a_ready(cur);
    if constexpr (SP2) {
        PG8_STAGE(PG8_SB(0, 0), cB, voffB); PG8_STAGE(PG8_SB(0, 1), cB + hstep, voffB); PG8_STAGE(PG8_SA(0, 0), cA, voffA); PG8_STAGE(PG8_SA(0, 1), cA + hstep, voffA);
        if (wr == 1) PG8_BAR;
        PG8_WAIT_V(2); PG8_BAR;
        PG8_STAGE(PG8_SB(1, 0), cB + kstep, voffB); PG8_STAGE(PG8_SA(1, 0), cA + kstep, voffA); PG8_STAGE(PG8_SB(1, 1), cB + hstep + kstep, voffB);
        PG8_WAIT_V(6); PG8_BAR;
    } else {
        PG8_STAGE(PG8_SB(0, 0), cB, voffB); PG8_STAGE(PG8_SA(0, 0), cA, voffA); PG8_STAGE(PG8_SB(0, 1), cB + hstep, voffB); PG8_STAGE(PG8_SA(0, 1), cA + hstep, voffA);
        if (wr == 1) PG8_BAR;
        PG8_WAIT_V(4); PG8_BAR;
        PG8_STAGE(PG8_SB(1, 0), cB + kstep, voffB); PG8_STAGE(PG8_SA(1, 0), cA + kstep, voffA); PG8_STAGE(PG8_SB(1, 1), cB + hstep + kstep, voffB);
        PG8_WAIT_V(6); PG8_BAR;
    }
    for (;;) {
        const bool has_next = S.next(ui + 1, nxt);
        const char* nA = has_next ? (const char*)g.A + (size_t)nxt.pm * tstep : cA; const char* nB = has_next ? (const char*)g.Bt + (size_t)nxt.pn * tstep : cB;
        for (int t = 0; t < nt; t += 2) {
            if constexpr (Epi::MID_T > 0) { if (t == Epi::MID_T) E.mid(acc, cur, wr, wc, fr, fq); }
            const bool last = (t == nt - 2);
            const char* a1 = cA + (size_t)(t + 1) * kstep;
            const char* a2 = last ? nA : cA + (size_t)(t + 2) * kstep; const char* b2 = last ? nB : cB + (size_t)(t + 2) * kstep;
            const char* a3 = a2 + kstep; const char* b3 = b2 + kstep;
            if (last && has_next) S.a_ready(nxt);
            if constexpr (SP2) {
            PG8_LDB(B0, 0, 0); PG8_LDB(B1, 0, 1); PG8_SCHED; PG8_LDA(At, 0, 0); PG8_STAGE(PG8_SA(1, 1), a1 + hstep, voffA);
            PG8_WAIT_V(8); PG8_WAIT_L(0); PG8_BAR; PG8_MMA(0, 0, At, B0); PG8_MMA(0, 1, At, B1); PG8_BAR; PG8_SCHED;
            PG8_LDA(At, 0, 1); PG8_STAGE(PG8_SB(0, 0), b2, voffB); PG8_STAGE(PG8_SB(0, 1), b2 + hstep, voffB); PG8_STAGE(PG8_SA(0, 0), a2, voffA);
            PG8_WAIT_V(8); PG8_WAIT_L(0); PG8_BAR; PG8_MMA(1, 0, At, B0); PG8_MMA(1, 1, At, B1); PG8_BAR; PG8_SCHED;
            PG8_LDB(B0, 1, 0); PG8_LDB(B1, 1, 1); PG8_SCHED; PG8_LDA(At, 1, 0); PG8_STAGE(PG8_SA(0, 1), a2 + hstep, voffA);
            PG8_WAIT_V(8); PG8_WAIT_L(0); PG8_BAR; PG8_MMA(0, 0, At, B0); PG8_MMA(0, 1, At, B1); PG8_BAR; PG8_SCHED;
            PG8_LDA(At, 1, 1); PG8_STAGE(PG8_SB(1, 0), b3, voffB); PG8_STAGE(PG8_SB(1, 1), b3 + hstep, voffB); PG8_STAGE(PG8_SA(1, 0), a3, voffA);
            PG8_WAIT_V(8); PG8_WAIT_L(0); PG8_BAR; PG8_MMA(1, 0, At, B0); PG8_MMA(1, 1, At, B1); PG8_BAR; PG8_SCHED;
            } else {
            PG8_LDB(B0, 0, 0); PG8_SCHED; PG8_LDA(At, 0, 0); PG8_STAGE(PG8_SA(1, 1), a1 + hstep, voffA);
            PG8_WAIT_L(8); PG8_BAR; PG8_WAIT_L(0); PG8_MMA(0, 0, At, B0); PG8_BAR; PG8_SCHED;
            PG8_LDB(B1, 0, 1); PG8_STAGE(PG8_SB(0, 0), b2, voffB);
            PG8_BAR; PG8_WAIT_L(0); PG8_MMA(0, 1, At, B1); PG8_BAR;
            PG8_LDA(At, 0, 1); PG8_STAGE(PG8_SA(0, 0), a2, voffA);
            PG8_BAR; PG8_WAIT_L(0); PG8_MMA(1, 0, At, B0); PG8_BAR; PG8_SCHED;
            PG8_STAGE(PG8_SB(0, 1), b2 + hstep, voffB);
            PG8_WAIT_V(6); PG8_BAR; PG8_MMA(1, 1, At, B1); PG8_BAR;
            PG8_LDB(B0, 1, 0); PG8_SCHED; PG8_LDA(At, 1, 0); PG8_STAGE(PG8_SA(0, 1), a2 + hstep, voffA);
            PG8_WAIT_L(8); PG8_BAR; PG8_WAIT_L(0); PG8_MMA(0, 0, At, B0); PG8_BAR; PG8_SCHED;
            PG8_LDB(B1, 1, 1); PG8_STAGE(PG8_SB(1, 0), b3, voffB);
            PG8_BAR; PG8_WAIT_L(0); PG8_MMA(0, 1, At, B1); PG8_BAR;
            PG8_LDA(At, 1, 1); PG8_STAGE(PG8_SA(1, 0), a3, voffA);
            PG8_BAR; PG8_WAIT_L(0); PG8_MMA(1, 0, At, B0); PG8_BAR; PG8_SCHED;
            PG8_STAGE(PG8_SB(1, 1), b3 + hstep, voffB);
            PG8_WAIT_V(6); PG8_BAR; PG8_MMA(1, 1, At, B1); PG8_BAR;
            }
        }
        if constexpr (ALIGN_EPI) { if (wr == 0) PG8_BAR; }
        E(acc, cur, wr, wc, fr, fq); S.done(cur);
        if (!has_next) break;
#pragma unroll
        for (int a = 0; a < 2; ++a)
#pragma unroll
            for (int b = 0; b < 2; ++b)
#pragma unroll
                for (int m = 0; m < 4; ++m)
#pragma unroll
                    for (int n = 0; n < 2; ++n) acc[a][b][m][n] = (f32x4){0.f, 0.f, 0.f, 0.f};
        cur = nxt; cA = nA; cB = nB; ++ui;
        if constexpr (ALIGN_EPI) { if (wr == 1) PG8_BAR; }
    }
    PG8_WAIT_V(0);
    if constexpr (!ALIGN_EPI) { if (wr == 0) PG8_BAR; }
    PG8_BAR;
#undef PG8_SA
#undef PG8_SB
#undef PG8_STAGE
#undef PG8_LDA
#undef PG8_LDB
#undef PG8_MMA
#undef PG8_WAIT_V
#undef PG8_WAIT_L
#undef PG8_BAR
#undef PG8_SCHED
}
}

#ifndef PG8_SP2
#define PG8_SP2 true
#endif
#ifndef PG8_ALIGN
#define PG8_ALIGN true
#endif

constexpr int NWAVES = 8;
constexpr int BATCH = 8, SEQ = 4096, DM = 1024, MTOK = BATCH * SEQ;
constexpr int NH = 4, DK = 128, DV = 256, QKW = 512, VW = 1024, CHUNK = 128, NCH = SEQ / CHUNK;
constexpr int PW = 512, DFF = 4096, INC = 5632;
constexpr int ZQ = 0, ZK = 512, ZV = 1024, ZG = 2048, ZPU = 3072, ZGT = 3584;
constexpr int N1 = 4608;
constexpr int M2 = 1536;
constexpr int K4 = 1536;
constexpr float EPS = 1e-6f;

constexpr size_t MiB = 1u << 20;
constexpr size_t WS_CTL = 0, CTL_ZERO_BYTES = 1 * MiB;
constexpr size_t WS_SS2 = 256 * 1024, WS_SS3 = 384 * 1024;
constexpr size_t WS_T1 = 2 * MiB;
constexpr size_t WS_T2C = 4 * MiB, WS_T2S = 5 * MiB;
constexpr size_t WS_DEC = 6 * MiB;
constexpr size_t WS_BT1 = 8 * MiB, WS_WT2 = 17 * MiB, WS_BT4 = 20 * MiB, WS_BT5 = 23 * MiB, WS_BT6 = 25 * MiB, WS_BT7 = 33 * MiB;
constexpr size_t WS_XN = 48 * MiB, WS_ST = 48 * MiB;
constexpr size_t WS_Q = 112 * MiB, WS_K = 144 * MiB, WS_KT = 176 * MiB, WS_VS = 208 * MiB, WS_SG = 272 * MiB, WS_PU = 336 * MiB, WS_GT = 368 * MiB;
constexpr size_t WS_MIX = 112 * MiB;
constexpr size_t WS_HID = 48 * MiB;
constexpr size_t WS_X1B = 304 * MiB, WS_X1 = 368 * MiB;
constexpr size_t WS_END = 496 * MiB;
static_assert(WS_BT7 + 8 * MiB <= WS_XN && WS_HID + 256 * MiB <= WS_X1B && WS_X1B + 64 * MiB <= WS_X1 && WS_X1 + 128 * MiB <= WS_END, "ws map");
constexpr int CW_TMO = 0, CW_CODE = 1, CW_BAR = 4096;
constexpr int RPITCH = K4;

constexpr int RING_OFF = 0, RING_BYTES = 131072;
constexpr int LDSCTL_OFF = RING_BYTES, MISC_OFF = LDSCTL_OFF + 320;
constexpr int LDS_BYTES = 147456;

#define GAS __attribute__((address_space(1)))
#define LAS __attribute__((address_space(3)))
typedef unsigned short bf16;
typedef unsigned v4u __attribute__((ext_vector_type(4)));
typedef unsigned v2u __attribute__((ext_vector_type(2)));
typedef float f32x4 __attribute__((ext_vector_type(4)));
typedef short bf16x8 __attribute__((ext_vector_type(8)));
typedef GAS unsigned gu32;
#define RLX_AGENT __ATOMIC_RELAXED, __HIP_MEMORY_SCOPE_AGENT
#define LDS_WAIT() asm volatile("s_waitcnt lgkmcnt(0)" ::: "memory")
#define VM_WAIT() asm volatile("s_waitcnt vmcnt(0)" ::: "memory")
__device__ __forceinline__ unsigned f2bf(float f) { unsigned u = __builtin_bit_cast(unsigned, f); return (u + 0x7fffu + ((u >> 16) & 1u)) >> 16; }
__device__ __forceinline__ unsigned pk2(float lo, float hi) { return f2bf(lo) | (f2bf(hi) << 16); }
using pg8::cvt_pk_bf16; using pg8::pack8; using pg8::bf_lo; using pg8::bf_hi;

#define XB_TMO      128
#define XB_XCNT(j)  (256  + 64 * (j))
#define XB_XSUB(j)  (1280 + 64 * (j))
#define XB_XGEN(j)  (2304 + 64 * (j))
#define XB_TOP      3328
#define XB_TOPGEN   3392
#define XCD_BAR_WORDS 3456
#define XB_SPIN_CAP (1u << 18)
__device__ __forceinline__ unsigned xb_ld(unsigned* p)              { return __hip_atomic_load(p, __ATOMIC_RELAXED, __HIP_MEMORY_SCOPE_AGENT); }
__device__ __forceinline__ unsigned xb_add(unsigned* p, unsigned v) { return __hip_atomic_fetch_add(p, v, __ATOMIC_RELAXED, __HIP_MEMORY_SCOPE_AGENT); }
__device__ __forceinline__ unsigned xb_xcc_id() { return (unsigned)__builtin_amdgcn_s_getreg((3 << 11) | 20) & 0xFu; }
#define XB_SPIN(cond, bar) do { unsigned _sp = 0; while (cond) { __builtin_amdgcn_s_sleep(1); \
    if ((++_sp & 255u) == 0u) { if (xb_ld(&(bar)[XB_TMO])) break; if (_sp > XB_SPIN_CAP) { atomicAdd(&(bar)[XB_TMO], 1u); break; } } } } while (0)
struct XcdBarrier { unsigned* bar; unsigned x; volatile LAS unsigned* st; };
__device__ __forceinline__ XcdBarrier xcd_barrier_post(unsigned* bar, volatile LAS unsigned* st) {
    XcdBarrier b; b.bar = bar; b.x = xb_xcc_id(); b.st = st;
    if (threadIdx.x == 0) (void)xb_add(&bar[XB_XCNT(b.x)], 1u);
    return b;
}
__device__ __forceinline__ void xcd_barrier_complete(unsigned* bar, unsigned x, unsigned& nloc, unsigned& nx) {
    const unsigned G = gridDim.x * gridDim.y * gridDim.z;
    unsigned sum, cnt, mine, sp = 0u;
    for (;;) {
        sum = 0u; cnt = 0u; mine = 0u;
#pragma unroll
        for (unsigned j = 0; j < 16; ++j) { const unsigned c = xb_ld(&bar[XB_XCNT(j)]); sum += c; cnt += (c > 0u) ? 1u : 0u; mine = (j == x) ? c : mine; }
        if (sum == G) break;
        __builtin_amdgcn_s_sleep(1);
        if ((++sp & 255u) == 0u) { if (xb_ld(&bar[XB_TMO])) break; if (sp > XB_SPIN_CAP) { atomicAdd(&bar[XB_TMO], 1u); break; } }
    }
    nloc = mine > 0u ? mine : 1u; nx = cnt > 0u ? cnt : 1u;
}
__device__ __forceinline__ void xcd_barrier(const XcdBarrier& b) {
    asm volatile("s_waitcnt vmcnt(0)" ::: "memory");
    __syncthreads();
    if (threadIdx.x == 0) {
        unsigned* bar = b.bar;
        __builtin_amdgcn_s_waitcnt(0);
        unsigned nloc = b.st[0], nx = b.st[1];
        if (nloc == 0u) { xcd_barrier_complete(bar, b.x, nloc, nx); b.st[0] = nloc; b.st[1] = nx; }
        const unsigned old = xb_add(&bar[XB_XSUB(b.x)], 1u);
        const unsigned gen = old / nloc;
        if (old + 1u == (gen + 1u) * nloc) {
            __builtin_amdgcn_fence(__ATOMIC_RELEASE, "agent");
            asm volatile("s_waitcnt vmcnt(0)" ::: "memory");
            const unsigned og = xb_add(&bar[XB_TOP], 1u);
            const unsigned tg = og / nx;
            if (og + 1u == (tg + 1u) * nx) xb_add(&bar[XB_TOPGEN], 1u);
            else XB_SPIN(xb_ld(&bar[XB_TOPGEN]) == tg, bar);
            __builtin_amdgcn_fence(__ATOMIC_ACQUIRE, "agent");
            xb_add(&bar[XB_XGEN(b.x)], 1u);
            asm volatile("s_waitcnt vmcnt(0)" ::: "memory");
        } else {
            XB_SPIN(xb_ld(&bar[XB_XGEN(b.x)]) == gen, bar);
            __builtin_amdgcn_fence(__ATOMIC_ACQUIRE, "agent");
            asm volatile("s_waitcnt vmcnt(0)" ::: "memory");
        }
    }
    __syncthreads();
}

struct Args {
    const float* in[14]; float* out; unsigned char* ws;
    double invf[64];
    float lg[4], g1[4], g127[4], g128[4];
    int ph_lo, ph_hi;
};
struct Frame {
    LAS unsigned char* lds; gu32* ctl;
    int tid, lane, wave, vcu, G;
    unsigned char* ws; float* out;
};
__device__ __forceinline__ float wave_sum(float v) {
#pragma unroll
    for (int o = 1; o < 64; o <<= 1) v += __shfl_xor(v, o);
    return v;
}

__device__ __forceinline__ void tr_item(const float* W, int ldw, int k0, int scol0, const float* kscale, bf16* WT, int dpitch, int drow0, LAS float* scr, int lane) {
#pragma unroll 8
    for (int i = 0; i < 32; ++i) { const int kk = 2 * i + (lane >> 5); float v = W[(size_t)(k0 + kk) * ldw + scol0 + (lane & 31)]; if (kscale) v *= kscale[k0 + kk]; scr[kk * 33 + (lane & 31)] = v; }
    LDS_WAIT(); asm volatile("" ::: "memory");
    const int c = lane & 7;
#pragma unroll
    for (int j = 0; j < 4; ++j) { const int n = (lane >> 3) + 8 * j; const LAS float* s = scr + (8 * c) * 33 + n;
        v4u o; o.x = pk2(s[0 * 33], s[1 * 33]); o.y = pk2(s[2 * 33], s[3 * 33]); o.z = pk2(s[4 * 33], s[5 * 33]); o.w = pk2(s[6 * 33], s[7 * 33]);
        *(GAS v4u*)(WT + (size_t)(drow0 + n) * dpitch + k0 + 8 * c) = o; }
    LDS_WAIT(); asm volatile("" ::: "memory");
}
__device__ __forceinline__ int bt1_src_col(int p0) {
    if (p0 < 1024) { const int pn = p0 >> 8, pp = p0 & 255, bj = pp >> 7, hh = (pp >> 6) & 1, dd0 = pp & 63; return (pn >> 1) * 512 + (pn & 1) * 256 + 128 * hh + 64 * bj + dd0; }
    if (p0 < 2048) return ZG + (p0 - 1024);
    if (p0 < 2560) return ZPU + (p0 - 2048);
    return ZGT + (p0 - 2560);
}
__device__ __forceinline__ int wt2_src_col(int r0) {
    if (r0 < 512) { const int pm = r0 >> 8, rr = r0 & 255, ai = rr >> 7, hh = (rr >> 6) & 1, dd0 = rr & 63; return ZK + pm * 256 + 128 * hh + 64 * ai + dd0; }
    return ZV + (r0 - 512);
}
__device__ __forceinline__ void sincos_d(double ang, float& c, float& s) {
    const double TWO_PI = 6.283185307179586476925286766559, TWO_PI_LO = 2.4492935982947064e-16, INV = 0.15915494309189533576888376337251;
    const double k = __builtin_rint(ang * INV); double r = __builtin_fma(-k, TWO_PI, ang);
    r = __builtin_fma(-k, TWO_PI_LO, r);
    const double HPI = 1.5707963267948966192313216916398;
    const double qd = __builtin_rint(r / HPI); const int qi = (int)qd; const double y = r - qd * HPI;
    const double y2 = y * y;
    double sp = -1.0 / 1307674368000.0; sp = sp * y2 + 1.0 / 6227020800.0; sp = sp * y2 - 1.0 / 39916800.0; sp = sp * y2 + 1.0 / 362880.0; sp = sp * y2 - 1.0 / 5040.0; sp = sp * y2 + 1.0 / 120.0; sp = sp * y2 - 1.0 / 6.0; sp = sp * y2 * y + y;
    double cp = 1.0 / 87178291200.0; cp = cp * y2 - 1.0 / 479001600.0; cp = cp * y2 + 1.0 / 3628800.0; cp = cp * y2 - 1.0 / 40320.0; cp = cp * y2 + 1.0 / 720.0; cp = cp * y2 - 1.0 / 24.0; cp = cp * y2 + 0.5; cp = 1.0 - cp * y2;
    double sv, cv;
    switch (qi & 3) { case 0: sv = sp; cv = cp; break; case 1: sv = cp; cv = -sp; break; case 2: sv = -sp; cv = -cp; break; default: sv = -cp; cv = sp; break; }
    c = (float)cv; s = (float)sv;
}
__device__ __forceinline__ void p0_prologue(Frame& F, const __attribute__((address_space(4))) Args* Ap) {
    const __attribute__((address_space(4))) Args& A = *Ap;
    const float* x = A.in[0]; const float* ln_mix = A.in[1]; const float* w_in = A.in[2]; const float* gn_gain = A.in[4]; const float* w_ret_up = A.in[5];
    const float* pool_w = A.in[6]; const float* pool_scale = A.in[7]; const float* w_pool_up = A.in[8]; const float* w_o = A.in[9]; const float* ln_mlp = A.in[10];
    const float* w_up = A.in[11]; const float* w_down = A.in[12];
    bf16* BT1 = (bf16*)(F.ws + WS_BT1); bf16* WT2 = (bf16*)(F.ws + WS_WT2); bf16* BT4 = (bf16*)(F.ws + WS_BT4); bf16* BT5 = (bf16*)(F.ws + WS_BT5); bf16* BT6 = (bf16*)(F.ws + WS_BT6); bf16* BT7 = (bf16*)(F.ws + WS_BT7);
    LAS float* scr = (LAS float*)(F.lds + RING_OFF + F.wave * 16384);
    const int gw = F.vcu * NWAVES + F.wave, NGW = F.G * NWAVES;
    constexpr int I1 = 16 * (N1 / 32), I2 = 16 * (M2 / 32), I4 = 16 * 32, I5 = 16 * 32, I6 = 16 * (DFF / 32), I7 = 64 * 32;
    constexpr int NITEMS = I1 + I2 + I4 + I5 + I6 + I7;
    for (int it = gw; it < NITEMS; it += NGW) {
        int r = it;
        if (r < I1) { const int nb = r % (N1 / 32), kb = r / (N1 / 32); tr_item(w_in, INC, 64 * kb, bt1_src_col(32 * nb), ln_mix, BT1, DM, 32 * nb, scr, F.lane); continue; } r -= I1;
        if (r < I2) { const int nb = r % (M2 / 32), kb = r / (M2 / 32); tr_item(w_in, INC, 64 * kb, wt2_src_col(32 * nb), ln_mix, WT2, DM, 32 * nb, scr, F.lane); continue; } r -= I2;
        if (r < I4) { const int nb = r % 32, kb = r / 32; tr_item(w_ret_up, DM, 64 * kb, 32 * nb, gn_gain, BT4, K4, 32 * nb, scr, F.lane); continue; } r -= I4;
        if (r < I5) { const int nb = r % 32, kb = r / 32; tr_item(w_o, DM, 64 * kb, 32 * nb, nullptr, BT5, DM, 32 * nb, scr, F.lane); continue; } r -= I5;
        if (r < I6) { const int nb = r % (DFF / 32), kb = r / (DFF / 32); tr_item(w_up, DFF, 64 * kb, 32 * nb, ln_mlp, BT6, DM, 32 * nb, scr, F.lane); continue; } r -= I6;
        { const int nb = r % 32, kb = r / 32; tr_item(w_down, DM, 64 * kb, 32 * nb, nullptr, BT7, DFF, 32 * nb, scr, F.lane); }
    }
    for (int it = gw; it < 4 * 16 * 16; it += NGW) {
        const int g = it >> 8, cb = (it >> 4) & 15, nb = it & 15, n = nb * 64 + F.lane, c0 = cb * 8;
        float a[8];
#pragma unroll
        for (int i = 0; i < 8; ++i) a[i] = 0.f;
        for (int j = 0; j < 128; ++j) {
            const float w = w_pool_up[(size_t)(g * 128 + j) * DM + n] * pool_scale[g * 128 + j];
#pragma unroll
            for (int i = 0; i < 8; ++i) a[i] += pool_w[(size_t)(g * 128 + c0 + i) * 128 + j] * w;
        }
        v4u o; o.x = pk2(a[0], a[1]); o.y = pk2(a[2], a[3]); o.z = pk2(a[4], a[5]); o.w = pk2(a[6], a[7]);
        *(GAS v4u*)(BT4 + (size_t)n * K4 + 1024 + g * 128 + c0) = o;
    }
    bf16* XN = (bf16*)(F.ws + WS_XN);
    for (int m = gw; m < MTOK; m += NGW) {
        const GAS f32x4* xr = (const GAS f32x4*)(x + (size_t)m * DM) + F.lane;
        f32x4 v[4]; float s = 0.f;
#pragma unroll
        for (int j = 0; j < 4; ++j) { v[j] = xr[64 * j]; s += (v[j].x * v[j].x + v[j].y * v[j].y) + (v[j].z * v[j].z + v[j].w * v[j].w); }
        const float rstd = 1.f / sqrtf(wave_sum(s) * (1.f / DM) + EPS);
        GAS unsigned long long* o8 = (GAS unsigned long long*)(XN + (size_t)m * DM) + F.lane;
#pragma unroll
        for (int j = 0; j < 4; ++j) o8[64 * j] = (unsigned long long)pk2(v[j].x * rstd, v[j].y * rstd) | ((unsigned long long)pk2(v[j].z * rstd, v[j].w * rstd) << 32);
    }
    float* T1 = (float*)(F.ws + WS_T1); float* T2C = (float*)(F.ws + WS_T2C); float* T2S = (float*)(F.ws + WS_T2S); float* DEC = (float*)(F.ws + WS_DEC);
    const int gt = F.vcu * NWAVES * 64 + F.tid, NGT = F.G * NWAVES * 64;
    for (int i = gt; i < SEQ * 64; i += NGT) {
        const int pos = i >> 6, dd = i & 63; float c, s; sincos_d((double)pos * A.invf[dd], c, s);
        T1[pos * 128 + dd] = c; T1[pos * 128 + 64 + dd] = s; T2C[dd * SEQ + pos] = c; T2S[dd * SEQ + pos] = s;
    }
    if (gt < 512) { const int h = gt >> 7, m = gt & 127; DEC[gt] = expf(-(float)m * A.lg[h]); }
}

struct EpiIn {
    static constexpr bool PERM = true; static constexpr int MID_T = 0;
    unsigned char* ws; const float* bgate;
    __device__ __forceinline__ void operator()(const f32x4 (&acc)[2][2][4][2], const pg8::Unit& u, int wr, int wc, int fr, int fq) const {
        const int row0 = u.pm * 256 + wr * 64 + fr;
        bf16* const SG = (bf16*)(ws + WS_SG); bf16* const PU = (bf16*)(ws + WS_PU); bf16* const GT = (bf16*)(ws + WS_GT); const float* const T1 = (const float*)(ws + WS_T1);
        if (u.pn < 4) {
            bf16* dst = (bf16*)(ws + ((u.pn < 2) ? WS_Q : WS_K)); const float sc = (u.pn < 2) ? 0.08838834764831845f : 1.0f;
            const int head = 2 * (u.pn & 1) + (wc >> 1), dd0 = 32 * (wc & 1) + 8 * fq;
#pragma unroll
            for (int ai = 0; ai < 2; ++ai)
#pragma unroll
                for (int m = 0; m < 4; ++m) {
                    const int row = row0 + ai * 128 + m * 16; const float* t = T1 + (size_t)(row & (SEQ - 1)) * 128 + dd0;
                    const f32x4 c0 = *(const f32x4*)t, c1 = *(const f32x4*)(t + 4), s0 = *(const f32x4*)(t + 64), s1 = *(const f32x4*)(t + 68);
                    const f32x4 a0 = acc[ai][0][m][0], a1 = acc[ai][0][m][1], b0 = acc[ai][1][m][0], b1 = acc[ai][1][m][1];
                    const f32x4 o10 = (a0 * c0 - b0 * s0) * sc, o11 = (a1 * c1 - b1 * s1) * sc, o20 = (a0 * s0 + b0 * c0) * sc, o21 = (a1 * s1 + b1 * c1) * sc;
                    bf16* p = dst + (size_t)row * QKW + head * 128 + dd0;
                    *(v4u*)p = pack8(o10, o11); *(v4u*)(p + 64) = pack8(o20, o21);
                    if (m & 1) asm volatile("" ::: "memory");
                }
        } else if (u.pn < 8) {
            const int col0 = (u.pn - 4) * 256 + wc * 32 + 8 * fq;
#pragma unroll
            for (int ai = 0; ai < 2; ++ai)
#pragma unroll
                for (int m = 0; m < 4; ++m)
#pragma unroll
                    for (int bj = 0; bj < 2; ++bj) {
                        f32x4 v[2];
#pragma unroll
                        for (int n = 0; n < 2; ++n)
#pragma unroll
                            for (int j = 0; j < 4; ++j) { const float a = acc[ai][bj][m][n][j]; v[n][j] = a * __builtin_amdgcn_rcpf(1.0f + __expf(-a)); }
                        *(v4u*)(SG + (size_t)(row0 + ai * 128 + m * 16) * VW + col0 + bj * 128) = pack8(v[0], v[1]);
                    }
        } else if (u.pn < 10) {
            const int col0 = (u.pn - 8) * 256 + wc * 32 + 8 * fq;
#pragma unroll
            for (int ai = 0; ai < 2; ++ai)
#pragma unroll
                for (int m = 0; m < 4; ++m)
#pragma unroll
                    for (int bj = 0; bj < 2; ++bj) *(v4u*)(PU + (size_t)(row0 + ai * 128 + m * 16) * PW + col0 + bj * 128) = pack8(acc[ai][bj][m][0], acc[ai][bj][m][1]);
        } else {
            const int col0 = (u.pn - 10) * 256 + wc * 32 + 8 * fq;
            f32x4 bv[2][2];
#pragma unroll
            for (int bj = 0; bj < 2; ++bj)
#pragma unroll
                for (int n = 0; n < 2; ++n) bv[bj][n] = *(const f32x4*)(bgate + col0 + bj * 128 + 4 * n);
#pragma unroll
            for (int ai = 0; ai < 2; ++ai)
#pragma unroll
                for (int m = 0; m < 4; ++m)
#pragma unroll
                    for (int bj = 0; bj < 2; ++bj) {
                        f32x4 v[2];
#pragma unroll
                        for (int n = 0; n < 2; ++n)
#pragma unroll
                            for (int j = 0; j < 4; ++j) { const float a = acc[ai][bj][m][n][j] + bv[bj][n][j]; v[n][j] = __builtin_amdgcn_rcpf(1.0f + __expf(-a)); }
                        *(v4u*)(GT + (size_t)(row0 + ai * 128 + m * 16) * 2048 + col0 + bj * 128) = pack8(v[0], v[1]);
                    }
        }
    }
};
struct EpiInT {
    static constexpr bool PERM = true; static constexpr int MID_T = 0;
    unsigned char* ws;
    __device__ __forceinline__ void operator()(const f32x4 (&acc)[2][2][4][2], const pg8::Unit& u, int wr, int wc, int fr, int fq) const {
        const int tok0 = u.pn * 256 + wc * 32 + 8 * fq;
        if (u.pm < 2) {
            GAS unsigned char* const KT = (GAS unsigned char*)(ws + WS_KT); const GAS unsigned char* const T2C = (const GAS unsigned char*)(ws + WS_T2C); const GAS unsigned char* const T2S = (const GAS unsigned char*)(ws + WS_T2S);
            const int head = 2 * u.pm + wr;
#pragma unroll
            for (int m = 0; m < 4; ++m) {
                const int dd = 16 * m + fr;
#pragma unroll
                for (int bj = 0; bj < 2; ++bj) {
                    const int tok = tok0 + bj * 128, pos = tok & (SEQ - 1);
                    const unsigned toff = (unsigned)(dd * SEQ + pos) * 4u;
                    const f32x4 c0 = *(const GAS f32x4*)(T2C + toff), c1 = *(const GAS f32x4*)(T2C + toff + 16), s0 = *(const GAS f32x4*)(T2S + toff), s1 = *(const GAS f32x4*)(T2S + toff + 16);
                    const f32x4 a0 = acc[0][bj][m][0], a1 = acc[0][bj][m][1], b0 = acc[1][bj][m][0], b1 = acc[1][bj][m][1];
                    const unsigned koff = (unsigned)((((tok >> 7) * NH + head) * 128 + dd) * 128 + (tok & 127)) * 2u;
                    *(GAS v4u*)(KT + koff) = pack8(a0 * c0 - b0 * s0, a1 * c1 - b1 * s1);
                    *(GAS v4u*)(KT + koff + (unsigned)(64 * 128 * 2)) = pack8(a0 * s0 + b0 * c0, a1 * s1 + b1 * c1);
                    asm volatile("" ::: "memory");
                }
            }
        } else {
            GAS unsigned char* const VS = (GAS unsigned char*)(ws + WS_VS); const GAS float* const DEC = (const GAS float*)(ws + WS_DEC);
            const int head = u.pm - 2; const GAS float* d = DEC + head * 128 + wc * 32 + 8 * fq;
            const f32x4 d0 = *(const GAS f32x4*)d, d1 = *(const GAS f32x4*)(d + 4);
#pragma unroll
            for (int ai = 0; ai < 2; ++ai)
#pragma unroll
                for (int m = 0; m < 4; ++m) {
#pragma unroll
                    for (int bj = 0; bj < 2; ++bj)
                        *(GAS v4u*)(VS + (unsigned)(((((tok0 >> 7) + bj) * NH + head) * 256 + ai * 128 + wr * 64 + m * 16 + fr) * 128 + (tok0 & 127)) * 2u) = pack8(acc[ai][bj][m][0] * d0, acc[ai][bj][m][1] * d1);
                    asm volatile("" ::: "memory");
                }
        }
    }
};

__device__ __forceinline__ void p2_scan_pool(Frame& F, const __attribute__((address_space(4))) Args* Ap) {
    const __attribute__((address_space(4))) Args& A = *Ap;
#if defined(DBG_STAMP) && DBG_STAMP == 102
    if (blockIdx.x == 0 && threadIdx.x == 0) { volatile LAS unsigned* M_ = (volatile LAS unsigned*)(F.lds + MISC_OFF); M_[18] = (unsigned)__builtin_amdgcn_s_memrealtime(); }
#endif
    const bf16* KT = (const bf16*)(F.ws + WS_KT); const bf16* VS = (const bf16*)(F.ws + WS_VS); bf16* ST = (bf16*)(F.ws + WS_ST);
    const int gw = F.vcu * NWAVES + F.wave, NGW = F.G * NWAVES; const int r = F.lane & 15, q = F.lane >> 4;
    for (int item = gw; item < 2048; item += NGW) {
        const int bh = item >> 6, es = (item >> 2) & 15, ds = item & 3, b = bh >> 2, h = bh & 3, e0 = 16 * es, d0 = 32 * ds;
        const bf16* ka = KT + ((size_t)((b * NCH) * NH + h) * 128 + d0 + r) * 128 + 8 * q;
        const bf16* vb = VS + ((size_t)((b * NCH) * NH + h) * 256 + e0 + r) * 128 + 8 * q;
        constexpr size_t KSTR = (size_t)NH * 128 * 128, VSTR = (size_t)NH * 256 * 128;
        const float g1 = A.g1[h], g127 = A.g127[h], g128 = A.g128[h];
        f32x4 s0 = {0.f, 0.f, 0.f, 0.f}, s1 = {0.f, 0.f, 0.f, 0.f};
        bf16x8 ra0[4][4], ra1[4][4], rb[4][4];
#define P2_LOAD(slot, n_) do { _Pragma("unroll") for (int ks = 0; ks < 4; ++ks) { ra0[slot][ks] = *(const bf16x8*)(ka + (size_t)(n_) * KSTR + 32 * ks); ra1[slot][ks] = *(const bf16x8*)(ka + (size_t)(n_) * KSTR + 16 * 128 + 32 * ks); rb[slot][ks] = *(const bf16x8*)(vb + (size_t)(n_) * VSTR + 32 * ks); } } while (0)
        P2_LOAD(0, 0); P2_LOAD(1, 1); P2_LOAD(2, 2);
        for (int n4 = 0; n4 < NCH; n4 += 4) {
#pragma unroll
            for (int j = 0; j < 4; ++j) {
                const int n = n4 + j;
                bf16* sp = ST + ((size_t)(((b * NCH + n) * NH + h) * 256 + e0 + r)) * 128 + d0 + 4 * q;
                { v2u w; w.x = cvt_pk_bf16(s0[0] * g1, s0[1] * g1); w.y = cvt_pk_bf16(s0[2] * g1, s0[3] * g1); *(v2u*)sp = w;
                  w.x = cvt_pk_bf16(s1[0] * g1, s1[1] * g1); w.y = cvt_pk_bf16(s1[2] * g1, s1[3] * g1); *(v2u*)(sp + 16) = w; }
                { const int nn = (n + 3 < NCH) ? n + 3 : NCH - 1; P2_LOAD((j + 3) & 3, nn); }
                f32x4 c0 = {0.f, 0.f, 0.f, 0.f}, c1 = {0.f, 0.f, 0.f, 0.f};
#pragma unroll
                for (int ks = 0; ks < 4; ++ks) { c0 = __builtin_amdgcn_mfma_f32_16x16x32_bf16(ra0[j][ks], rb[j][ks], c0, 0, 0, 0); c1 = __builtin_amdgcn_mfma_f32_16x16x32_bf16(ra1[j][ks], rb[j][ks], c1, 0, 0, 0); }
                s0 = s0 * g128 + c0 * g127; s1 = s1 * g128 + c1 * g127;
            }
        }
#undef P2_LOAD
    }
#if defined(DBG_STAMP) && DBG_STAMP == 102
    if (blockIdx.x == 0 && threadIdx.x == 0) { volatile LAS unsigned* M_ = (volatile LAS unsigned*)(F.lds + MISC_OFF); M_[17] = (unsigned)__builtin_amdgcn_s_memrealtime() - M_[18]; }
#endif
    const bf16* PU = (const bf16*)(F.ws + WS_PU); bf16* RGP = (bf16*)F.out;
    for (int it = gw; it < (MTOK / 4) * 4; it += NGW) {
        const int g = it & 3, t = (it >> 2) * 4 + (F.lane >> 4), col0 = g * 128 + 8 * (F.lane & 15), pos = t & (SEQ - 1);
        float s[8];
#pragma unroll
        for (int k = 0; k < 8; ++k) s[k] = 0.f;
        const v4u u0 = *(const v4u*)(PU + (size_t)t * PW + col0);
#define POOL_W(W) do { v4u v[W]; _Pragma("unroll") for (int j = 0; j < W; ++j) { const int tj = (j <= pos) ? t - j : t; v[j] = *(const v4u*)(PU + (size_t)tj * PW + col0); } \
        _Pragma("unroll") for (int j = 0; j < W; ++j) { const float wj = (j <= pos) ? 1.0f : 0.0f; \
            s[0] += wj * bf_lo(v[j].x); s[1] += wj * bf_hi(v[j].x); s[2] += wj * bf_lo(v[j].y); s[3] += wj * bf_hi(v[j].y); s[4] += wj * bf_lo(v[j].z); s[5] += wj * bf_hi(v[j].z); s[6] += wj * bf_lo(v[j].w); s[7] += wj * bf_hi(v[j].w); } } while (0)
        if (g == 0) POOL_W(2); else if (g == 1) POOL_W(4); else if (g == 2) POOL_W(8); else POOL_W(16);
#undef POOL_W
        const int w = 2 << g, cnt = (pos + 1 < w) ? pos + 1 : w; const float ic = 1.0f / (float)cnt;
        v4u o; o.x = pk2(s[0] * ic - bf_lo(u0.x), s[1] * ic - bf_hi(u0.x)); o.y = pk2(s[2] * ic - bf_lo(u0.y), s[3] * ic - bf_hi(u0.y));
        o.z = pk2(s[4] * ic - bf_lo(u0.z), s[5] * ic - bf_hi(u0.z)); o.w = pk2(s[6] * ic - bf_lo(u0.w), s[7] * ic - bf_hi(u0.w));
        *(v4u*)(RGP + (size_t)t * RPITCH + 1024 + col0) = o;
    }
}

__device__ __forceinline__ void p3_retention(Frame& F, const __attribute__((address_space(4))) Args* Ap) {
    const __attribute__((address_space(4))) Args& A = *Ap;
    const bf16* Q = (const bf16*)(F.ws + WS_Q); const unsigned char* Kb = (const unsigned char*)(F.ws + WS_K); const unsigned char* VS = (const unsigned char*)(F.ws + WS_VS); const unsigned char* ST = (const unsigned char*)(F.ws + WS_ST);
    const bf16* SG = (const bf16*)(F.ws + WS_SG); bf16* RGP = (bf16*)F.out;
    const int r = F.lane & 15, q = F.lane >> 4, w = F.wave;
    LAS unsigned char* ring = F.lds + RING_OFF;
    unsigned gK[4], gV[4];
#pragma unroll
    for (int k = 0; k < 4; ++k) { const int row = (k * 8 + w) * 4 + (F.lane >> 4), pc = F.lane & 15;
        gK[k] = (unsigned)(row * 1024 + ((pc ^ ((row & 3) | (((row >> 3) & 3) << 2))) << 4)); gV[k] = (unsigned)(row * 256 + ((pc ^ (row & 15)) << 4)); }
    const unsigned rK = (unsigned)(8 * (r >> 2) + (r & 3)) * 256u, rV = (unsigned)r * 256u; unsigned xo[4];
#pragma unroll
    for (int ks = 0; ks < 4; ++ks) xo[ks] = (unsigned)(((4 * ks + q) ^ r) << 4);
#define P3_STAGE(slot, gbase, goff) do { _Pragma("unroll") for (int k_ = 0; k_ < 4; ++k_) \
        __builtin_amdgcn_global_load_lds((const unsigned*)((const unsigned char*)(gbase) + (goff)[k_]), (LAS unsigned*)(ring + (slot) * 32768 + (k_ * 8 + w) * 1024), 16, 0, 0); } while (0)
#define P3_SYNC() do { asm volatile("s_waitcnt vmcnt(0)" ::: "memory"); __builtin_amdgcn_s_barrier(); asm volatile("" ::: "memory"); } while (0)
    const int cl = 16 * w + r, nks = ((16 * w + 15) >> 5) + 1;
    int sp = 0;
    int unit = F.vcu;
    if (unit >= BATCH * NCH * NH) return;
    bf16x8 qf[4];
    { const int h = unit & 3, n = (unit >> 2) & 31, b = unit >> 7, tok0 = b * SEQ + n * CHUNK;
      P3_STAGE(sp & 3, Kb + ((size_t)tok0 * QKW + h * 128) * 2, gK);
#pragma unroll
      for (int ks = 0; ks < 4; ++ks) qf[ks] = *(const bf16x8*)(Q + (size_t)(tok0 + cl) * QKW + h * 128 + 32 * ks + 8 * q); }
    for (; unit < BATCH * NCH * NH; unit += F.G) {
        const int h = unit & 3, n = (unit >> 2) & 31, b = unit >> 7, tok0 = b * SEQ + n * CHUNK;
        const int sA = sp & 3, sB0 = (sp + 1) & 3, sB1 = (sp + 2) & 3, sC0 = (sp + 3) & 3, sC1 = (sp + 4) & 3; sp += 5;
        const unsigned char* vsb = VS + (size_t)((b * NCH + n) * NH + h) * 65536; const unsigned char* stb = ST + (size_t)((b * NCH + n) * NH + h) * 65536;
        P3_SYNC();
        P3_STAGE(sB0, vsb, gV); P3_STAGE(sB1, stb, gV);
        v2u gv[16];
        { const bf16* gp = SG + (size_t)(tok0 + cl) * VW + h * 256 + 4 * q;
#pragma unroll
          for (int g = 0; g < 16; ++g) gv[g] = *(const v2u*)(gp + 16 * g); }
        bf16x8 pf[4];
#pragma unroll
        for (int k2 = 0; k2 < 4; ++k2) {
            v4u pw = {0u, 0u, 0u, 0u};
            if (k2 < nks) {
                f32x4 sa = {0.f, 0.f, 0.f, 0.f}, sb = {0.f, 0.f, 0.f, 0.f};
                const LAS unsigned char* kp = ring + sA * 32768 + (32 * k2) * 256 + rK;
#pragma unroll
                for (int ks = 0; ks < 4; ++ks) {
                    const bf16x8 ka = *(const LAS bf16x8*)(kp + xo[ks]), kb = *(const LAS bf16x8*)(kp + 4 * 256 + xo[ks]);
                    sa = __builtin_amdgcn_mfma_f32_16x16x32_bf16(ka, qf[ks], sa, 0, 0, 0); sb = __builtin_amdgcn_mfma_f32_16x16x32_bf16(kb, qf[ks], sb, 0, 0, 0);
                }
                const int mb = 32 * k2 + 8 * q;
#pragma unroll
                for (int i = 0; i < 4; ++i) { if (mb + i > cl) sa[i] = 0.f; if (mb + 4 + i > cl) sb[i] = 0.f; }
                pw.x = cvt_pk_bf16(sa[0], sa[1]); pw.y = cvt_pk_bf16(sa[2], sa[3]); pw.z = cvt_pk_bf16(sb[0], sb[1]); pw.w = cvt_pk_bf16(sb[2], sb[3]);
            }
            pf[k2] = __builtin_bit_cast(bf16x8, pw);
        }
        f32x4 acc[16];
#pragma unroll
        for (int g = 0; g < 16; ++g) acc[g] = (f32x4){0.f, 0.f, 0.f, 0.f};
        const int nxt = unit + F.G; const bool has_next = nxt < BATCH * NCH * NH;
        bf16x8 nqf[4];
#pragma unroll
        for (int hf = 0; hf < 2; ++hf) {
            P3_SYNC();
            if (hf == 0) { P3_STAGE(sC0, vsb + 32768, gV); P3_STAGE(sC1, stb + 32768, gV); }
            else if (has_next) { const int h2 = nxt & 3, n2 = (nxt >> 2) & 31, b2 = nxt >> 7, t2 = b2 * SEQ + n2 * CHUNK;
                P3_STAGE(sp & 3, Kb + ((size_t)t2 * QKW + h2 * 128) * 2, gK);
#pragma unroll
                for (int ks = 0; ks < 4; ++ks) nqf[ks] = *(const bf16x8*)(Q + (size_t)(t2 + cl) * QKW + h2 * 128 + 32 * ks + 8 * q); }
            const LAS unsigned char* vp = ring + (hf == 0 ? sB0 : sC0) * 32768 + rV; const LAS unsigned char* spp = ring + (hf == 0 ? sB1 : sC1) * 32768 + rV;
#pragma unroll
            for (int ks = 0; ks < 4; ++ks) {
                if (ks < nks) {
#pragma unroll
                    for (int g = 0; g < 8; ++g) { const bf16x8 vf = *(const LAS bf16x8*)(vp + g * 4096 + xo[ks]); acc[8 * hf + g] = __builtin_amdgcn_mfma_f32_16x16x32_bf16(vf, pf[ks], acc[8 * hf + g], 0, 0, 0); }
                }
            }
#pragma unroll
            for (int ks = 0; ks < 4; ++ks)
#pragma unroll
                for (int g = 0; g < 8; ++g) { const bf16x8 sf = *(const LAS bf16x8*)(spp + g * 4096 + xo[ks]); acc[8 * hf + g] = __builtin_amdgcn_mfma_f32_16x16x32_bf16(sf, qf[ks], acc[8 * hf + g], 0, 0, 0); }
        }
        const float rs = __expf((float)cl * A.lg[h]);
        float sm = 0.f;
#pragma unroll
        for (int g = 0; g < 16; ++g) { acc[g] = acc[g] * rs; sm += (acc[g][0] + acc[g][1]) + (acc[g][2] + acc[g][3]); }
        sm += __shfl_xor(sm, 16); sm += __shfl_xor(sm, 32);
        const float mu = sm * (1.0f / 256.0f); float v = 0.f;
#pragma unroll
        for (int g = 0; g < 16; ++g) { acc[g] = acc[g] - mu; v += (acc[g][0] * acc[g][0] + acc[g][1] * acc[g][1]) + (acc[g][2] * acc[g][2] + acc[g][3] * acc[g][3]); }
        v += __shfl_xor(v, 16); v += __shfl_xor(v, 32);
        const float rstd = 1.0f / sqrtf(v * (1.0f / 256.0f) + EPS);
        bf16* op = RGP + (size_t)(tok0 + cl) * RPITCH + h * 256 + 4 * q;
#pragma unroll
        for (int g = 0; g < 16; ++g) {
            v2u o; o.x = cvt_pk_bf16(acc[g][0] * rstd * bf_lo(gv[g].x), acc[g][1] * rstd * bf_hi(gv[g].x)); o.y = cvt_pk_bf16(acc[g][2] * rstd * bf_lo(gv[g].y), acc[g][3] * rstd * bf_hi(gv[g].y));
            *(v2u*)(op + 16 * g) = o;
        }
        if (has_next) {
#pragma unroll
            for (int ks = 0; ks < 4; ++ks) qf[ks] = nqf[ks];
        }
    }
    P3_SYNC();
#undef P3_STAGE
#undef P3_SYNC
}

struct EpiMix {
    static constexpr bool PERM = true; static constexpr int MID_T = 16;
    unsigned char* ws;
    __device__ __forceinline__ void mid(f32x4 (&acc)[2][2][4][2], const pg8::Unit& u, int wr, int wc, int fr, int fq) const {
        const int row0 = u.pm * 256 + wr * 64 + fr, col0 = u.pn * 256 + wc * 32 + 8 * fq;
        const GAS unsigned char* gbase = (const GAS unsigned char*)(ws + WS_GT);
        unsigned goff = (unsigned)(row0 * 2048 + col0) * 2u;
#pragma unroll
        for (int ai = 0; ai < 2; ++ai)
#pragma unroll
            for (int m = 0; m < 4; ++m) {
                asm volatile("" : "+v"(goff));
#pragma unroll
                for (int bj = 0; bj < 2; ++bj) {
                    const GAS unsigned char* gp = gbase + (goff + (unsigned)((ai * 128 + m * 16) * 4096 + bj * 256));
                    const v4u ga = *(const GAS v4u*)gp, gb = *(const GAS v4u*)(gp + 2048);
                    f32x4 r0, r1;
                    r0[0] = bf_lo(ga.x) * __builtin_amdgcn_rcpf(bf_lo(gb.x)); r0[1] = bf_hi(ga.x) * __builtin_amdgcn_rcpf(bf_hi(gb.x)); r0[2] = bf_lo(ga.y) * __builtin_amdgcn_rcpf(bf_lo(gb.y)); r0[3] = bf_hi(ga.y) * __builtin_amdgcn_rcpf(bf_hi(gb.y));
                    r1[0] = bf_lo(ga.z) * __builtin_amdgcn_rcpf(bf_lo(gb.z)); r1[1] = bf_hi(ga.z) * __builtin_amdgcn_rcpf(bf_hi(gb.z)); r1[2] = bf_lo(ga.w) * __builtin_amdgcn_rcpf(bf_lo(gb.w)); r1[3] = bf_hi(ga.w) * __builtin_amdgcn_rcpf(bf_hi(gb.w));
                    acc[ai][bj][m][0] = acc[ai][bj][m][0] * r0; acc[ai][bj][m][1] = acc[ai][bj][m][1] * r1;
                }
                asm volatile("" ::: "memory");
            }
    }
    __device__ __forceinline__ void operator()(const f32x4 (&acc)[2][2][4][2], const pg8::Unit& u, int wr, int wc, int fr, int fq) const {
        const int row0 = u.pm * 256 + wr * 64 + fr, col0 = u.pn * 256 + wc * 32 + 8 * fq;
        const bf16* const GT = (const bf16*)(ws + WS_GT); bf16* const MIX = (bf16*)(ws + WS_MIX);
#pragma unroll
        for (int ai = 0; ai < 2; ++ai)
#pragma unroll
            for (int m = 0; m < 4; ++m)
#pragma unroll
                for (int bj = 0; bj < 2; ++bj) {
                    const size_t row = (size_t)(row0 + ai * 128 + m * 16);
                    const v4u gb = *(const v4u*)(GT + row * 2048 + 1024 + col0 + bj * 128);
                    const f32x4 g0 = {bf_lo(gb.x), bf_hi(gb.x), bf_lo(gb.y), bf_hi(gb.y)}, g1 = {bf_lo(gb.z), bf_hi(gb.z), bf_lo(gb.w), bf_hi(gb.w)};
                    *(v4u*)(MIX + row * DM + col0 + bj * 128) = pack8(acc[ai][bj][m][0] * g0, acc[ai][bj][m][1] * g1);
                }
    }
};
template <bool WITH_B16> struct EpiRes {
    static constexpr bool PERM = false; static constexpr int MID_T = 0;
    unsigned char* ws; const float* xin; float* dout;
    __device__ __forceinline__ void operator()(const f32x4 (&acc)[2][2][4][2], const pg8::Unit& u, int wr, int wc, int fr, int fq) const {
        const int row0 = u.pm * 256 + wr * 64 + fr, col0 = u.pn * 256 + wc * 32 + 4 * fq;
        const float* const base = WITH_B16 ? xin : (const float*)(ws + WS_X1); float* const out = WITH_B16 ? (float*)(ws + WS_X1) : dout; bf16* const ob = (bf16*)(ws + WS_X1B); float* const ss = (float*)(ws + (WITH_B16 ? WS_SS2 : WS_SS3));
#pragma unroll
        for (int ai = 0; ai < 2; ++ai)
#pragma unroll
            for (int m = 0; m < 4; ++m) {
                const int row = row0 + ai * 128 + m * 16; const size_t off = (size_t)row * DM + col0; float s = 0.f;
#pragma unroll
                for (int bj = 0; bj < 2; ++bj)
#pragma unroll
                    for (int n = 0; n < 2; ++n) {
                        const f32x4 o = *(const f32x4*)(base + off + bj * 128 + n * 16) + acc[ai][bj][m][n];
                        *(f32x4*)(out + off + bj * 128 + n * 16) = o; s += (o[0] * o[0] + o[1] * o[1]) + (o[2] * o[2] + o[3] * o[3]);
                        if (WITH_B16) { v2u w; w.x = cvt_pk_bf16(o[0], o[1]); w.y = cvt_pk_bf16(o[2], o[3]); *(v2u*)(ob + off + bj * 128 + n * 16) = w; }
                    }
                s += __shfl_xor(s, 16); s += __shfl_xor(s, 32);
                if (fq == 0) atomicAdd(ss + row, s);
                if (m & 1) asm volatile("" ::: "memory");
            }
    }
};
struct EpiUp {
    static constexpr bool PERM = true; static constexpr int MID_T = 0;
    unsigned char* ws;
    __device__ __forceinline__ void operator()(const f32x4 (&acc)[2][2][4][2], const pg8::Unit& u, int wr, int wc, int fr, int fq) const {
        const int row0 = u.pm * 256 + wr * 64 + fr, col0 = u.pn * 256 + wc * 32 + 8 * fq;
        const float* const ss = (const float*)(ws + WS_SS2); bf16* const HID = (bf16*)(ws + WS_HID);
#pragma unroll
        for (int ai = 0; ai < 2; ++ai)
#pragma unroll
            for (int m = 0; m < 4; ++m) {
                const int row = row0 + ai * 128 + m * 16; const float rstd = 1.0f / sqrtf(ss[row] * (1.0f / DM) + EPS);
#pragma unroll
                for (int bj = 0; bj < 2; ++bj) {
                    f32x4 v[2];
#pragma unroll
                    for (int n = 0; n < 2; ++n)
#pragma unroll
                        for (int j = 0; j < 4; ++j) { const float a = fmaxf(acc[ai][bj][m][n][j] * rstd, 0.f); v[n][j] = a * a; }
                    *(v4u*)(HID + (size_t)row * DFF + col0 + bj * 128) = pack8(v[0], v[1]);
                }
            }
    }
};

typedef const __attribute__((address_space(4))) Args* KArgs;
#define KARGS() ({ KArgs p_ = (KArgs)__builtin_amdgcn_kernarg_segment_ptr(); asm volatile("" : "+s"(p_)); p_; })
__device__ __forceinline__ void frame_init(Frame& F, KArgs ap) {
    extern __shared__ __attribute__((aligned(16))) unsigned char lds[];
    F.lds = (LAS unsigned char*)lds;
    int t_ = threadIdx.x; asm volatile("" : "+v"(t_));
    F.tid = t_; F.lane = t_ & 63; F.wave = __builtin_amdgcn_readfirstlane(t_ >> 6);
    F.G = gridDim.x; { const int bx = blockIdx.x; F.vcu = (F.G % 8 == 0) ? (bx % 8) * (F.G / 8) + bx / 8 : bx; }
    F.ws = ap->ws; F.out = ap->out; F.ctl = (gu32*)(F.ws + WS_CTL);
}
__global__ void __launch_bounds__(NWAVES * 64, 2) skel_fwd(Args args_unused) {
    extern __shared__ __attribute__((aligned(16))) unsigned char lds[];
    {
        LAS unsigned char* L = (LAS unsigned char*)lds;
        for (int u = threadIdx.x; u < (LDS_BYTES - LDSCTL_OFF) / 4; u += NWAVES * 64) ((LAS unsigned*)(L + LDSCTL_OFF))[u] = 0u;
        __syncthreads();
        KArgs ap = KARGS();
        if (N_LAUNCHES == 1 && threadIdx.x == 0) (void)xb_add((unsigned*)(ap->ws + WS_CTL) + CW_BAR + XB_XCNT(xb_xcc_id()), 1u);
    }
#ifdef DBG_STOP
#define IN(k) ({ KArgs q_ = KARGS(); ((k) <= DBG_STOP && q_->ph_lo <= (k) && (k) < q_->ph_hi); })
#else
#define IN(k) ({ KArgs q_ = KARGS(); (q_->ph_lo <= (k) && (k) < q_->ph_hi); })
#endif
#define SEAM(k) do { if (N_LAUNCHES == 1) { KArgs q_ = KARGS(); if (q_->ph_lo <= (k) && (k) + 1 < q_->ph_hi) { XcdBarrier b_; b_.bar = (unsigned*)(q_->ws + WS_CTL) + CW_BAR; b_.x = xb_xcc_id(); \
        b_.st = (volatile LAS unsigned*)((LAS unsigned char*)lds + MISC_OFF) + 8; xcd_barrier(b_); } } } while (0)

#ifdef DBG_STAMP
#define ST_B(k) do { if ((k) == DBG_STAMP && blockIdx.x == 0 && threadIdx.x == 0) ((volatile LAS unsigned*)((LAS unsigned char*)lds + MISC_OFF))[16] = (unsigned)__builtin_amdgcn_s_memrealtime(); } while (0)
#define ST_E(k) do { if ((k) == DBG_STAMP && blockIdx.x == 0 && threadIdx.x == 0) { volatile LAS unsigned* M_ = (volatile LAS unsigned*)((LAS unsigned char*)lds + MISC_OFF); M_[17] = (unsigned)__builtin_amdgcn_s_memrealtime() - M_[16]; } } while (0)
#else
#define ST_B(k) do {} while (0)
#define ST_E(k) do {} while (0)
#endif
    ST_B(0); if (IN(0)) { KArgs ap = KARGS(); Frame F; frame_init(F, ap); p0_prologue(F, ap); } SEAM(0); ST_E(0);

    ST_B(1); if (IN(1)) {
        { KArgs ap = KARGS(); unsigned char* ws = ap->ws;
          pg8::Gemm g{(const bf16*)(ws + WS_XN), (const bf16*)(ws + WS_BT1), MTOK, N1, DM}; pg8::StaticOrder<MTOK, N1> S; S.init((int)gridDim.x, (int)blockIdx.x);
          EpiIn E{ws, ap->in[3]};
          pg8::gemm_phase<EpiIn, pg8::StaticOrder<MTOK, N1>, DM, PG8_ALIGN, PG8_SP2>((LAS unsigned char*)lds + RING_OFF, g, S, E); }
        { KArgs ap = KARGS(); unsigned char* ws = ap->ws;
          pg8::Gemm g{(const bf16*)(ws + WS_WT2), (const bf16*)(ws + WS_XN), M2, MTOK, DM}; pg8::StaticOrder<M2, MTOK> S; S.init((int)gridDim.x, (int)blockIdx.x);
          EpiInT E{ws};
          pg8::gemm_phase<EpiInT, pg8::StaticOrder<M2, MTOK>, DM, PG8_ALIGN, PG8_SP2>((LAS unsigned char*)lds + RING_OFF, g, S, E); }
    } SEAM(1); ST_E(1);

    ST_B(2); if (IN(2)) { KArgs ap = KARGS(); Frame F; frame_init(F, ap); p2_scan_pool(F, ap); } SEAM(2); ST_E(2);

    ST_B(3); if (IN(3)) { KArgs ap = KARGS(); Frame F; frame_init(F, ap); p3_retention(F, ap); } SEAM(3); ST_E(3);

    ST_B(4); if (IN(4)) {
        KArgs ap = KARGS(); unsigned char* ws = ap->ws;
        pg8::Gemm g{(const bf16*)ap->out, (const bf16*)(ws + WS_BT4), MTOK, DM, K4}; pg8::StaticOrder<MTOK, DM> S; S.init((int)gridDim.x, (int)blockIdx.x);
        EpiMix E{ws};
        pg8::gemm_phase<EpiMix, pg8::StaticOrder<MTOK, DM>, K4, PG8_ALIGN, PG8_SP2>((LAS unsigned char*)lds + RING_OFF, g, S, E);
    } SEAM(4); ST_E(4);

    ST_B(5); if (IN(5)) {
        KArgs ap = KARGS(); unsigned char* ws = ap->ws;
        pg8::Gemm g{(const bf16*)(ws + WS_MIX), (const bf16*)(ws + WS_BT5), MTOK, DM, DM}; pg8::StaticOrder<MTOK, DM> S; S.init((int)gridDim.x, (int)blockIdx.x);
        EpiRes<true> E{ws, ap->in[0], nullptr};
        pg8::gemm_phase<EpiRes<true>, pg8::StaticOrder<MTOK, DM>, DM, PG8_ALIGN, PG8_SP2>((LAS unsigned char*)lds + RING_OFF, g, S, E);
    } SEAM(5); ST_E(5);

    ST_B(6); if (IN(6)) {
        KArgs ap = KARGS(); unsigned char* ws = ap->ws;
        pg8::Gemm g{(const bf16*)(ws + WS_X1B), (const bf16*)(ws + WS_BT6), MTOK, DFF, DM}; pg8::StaticOrder<MTOK, DFF> S; S.init((int)gridDim.x, (int)blockIdx.x);
        EpiUp E{ws};
        pg8::gemm_phase<EpiUp, pg8::StaticOrder<MTOK, DFF>, DM, PG8_ALIGN, PG8_SP2>((LAS unsigned char*)lds + RING_OFF, g, S, E);
    } SEAM(6); ST_E(6);

    ST_B(7); if (IN(7)) {
        KArgs ap = KARGS(); unsigned char* ws = ap->ws;
        pg8::Gemm g{(const bf16*)(ws + WS_HID), (const bf16*)(ws + WS_BT7), MTOK, DM, DFF}; pg8::StaticOrder<MTOK, DM> S; S.init((int)gridDim.x, (int)blockIdx.x);
        EpiRes<false> E{ws, nullptr, ap->out};
        pg8::gemm_phase<EpiRes<false>, pg8::StaticOrder<MTOK, DM>, DFF, PG8_ALIGN, PG8_SP2>((LAS unsigned char*)lds + RING_OFF, g, S, E);
    } SEAM(7); ST_E(7);

    ST_B(8); if (IN(8)) {
        KArgs ap = KARGS(); Frame F; frame_init(F, ap);
        const float* lnf = ap->in[13]; const float* ss = (const float*)(F.ws + WS_SS3); float* outp = F.out;
        const int gw = F.vcu * NWAVES + F.wave, NGW = F.G * NWAVES;
        unsigned bad = (N_LAUNCHES == 1) ? (xb_ld((unsigned*)(F.ctl + CW_BAR) + XB_TMO) != 0u) : 0u;
        const float qn = __builtin_nanf("");
        f32x4 gv[4];
#pragma unroll
        for (int j = 0; j < 4; ++j) gv[j] = ((const GAS f32x4*)lnf)[64 * j + F.lane];
        for (int m = gw; m < MTOK; m += NGW) {
            GAS f32x4* o = (GAS f32x4*)(outp + (size_t)m * DM) + F.lane; const float rstd = 1.0f / sqrtf(ss[m] * (1.0f / DM) + EPS);
#pragma unroll
            for (int j = 0; j < 4; ++j) { f32x4 v = o[64 * j] * rstd * gv[j]; if (bad) v = (f32x4){qn, qn, qn, qn}; o[64 * j] = v; }
        }
    }
#ifdef DBG_STOP
    {
        KArgs ap = KARGS();
        if (ap->ph_hi == N_PHASES) {
            Frame F; frame_init(F, ap); const unsigned char* ws = F.ws; float* outp = F.out;
            const int gt = F.vcu * NWAVES * 64 + F.tid, NGT = F.G * NWAVES * 64;
            const size_t M16 = (size_t)1 << 24;
            for (size_t i = (DBG_STOP == 2 || DBG_STOP == 3) ? (size_t)gt + 25165824 : (size_t)gt; i < (size_t)MTOK * DM; i += NGT) {
                float v = 0.f;
#define BF(off, cnt) bf_lo((unsigned)((const bf16*)(ws + (off)))[i % (cnt)])
                if (DBG_STOP == 0) { v = BF(WS_XN, 2 * M16) + BF(WS_BT1, 4608 * 1024) + BF(WS_WT2, 1536 * 1024) + BF(WS_BT4, 1536 * 1024) + BF(WS_BT5, 1024 * 1024) + BF(WS_BT6, 4096 * 1024) + BF(WS_BT7, 4096 * 1024)
                                       + ((const float*)(ws + WS_T1))[i % (4096 * 128)] + ((const float*)(ws + WS_T2C))[i % (4096 * 64)] + ((const float*)(ws + WS_T2S))[i % (4096 * 64)] + ((const float*)(ws + WS_DEC))[i % 512]; }
                if (DBG_STOP == 1) { v = BF(WS_Q, M16) + BF(WS_K, M16) + BF(WS_KT, M16) + BF(WS_VS, 2 * M16) + BF(WS_SG, 2 * M16) + BF(WS_PU, M16) + BF(WS_GT, 4 * M16); }
                if (DBG_STOP == 2 || DBG_STOP == 3) { v = BF(WS_ST, 2 * M16); }
                if (DBG_STOP == 4) { v = BF(WS_MIX, 2 * M16); }
                if (DBG_STOP == 5) { v = BF(WS_X1B, 2 * M16) + ((const float*)(ws + WS_SS2))[i % MTOK]; }
                if (DBG_STOP == 6) { v = BF(WS_HID, 8 * M16); }
                outp[i] = v;
            }
        }
    }
#endif
    ST_E(8);
#ifdef DBG_STAMP
    { __syncthreads(); KArgs ap = KARGS(); if (blockIdx.x == 0 && threadIdx.x == 0) { asm volatile("s_waitcnt vmcnt(0)" ::: "memory"); ap->out[0] = 10.0f * __builtin_rintf((float)((volatile LAS unsigned*)((LAS unsigned char*)lds + MISC_OFF))[17] * 0.001f); } }
#endif
#undef IN
#undef SEAM
}

extern "C" void kernel_launch(void* const* d_in, const int* in_sizes, int n_in, void* d_out, int out_size, void* d_ws, size_t ws_size, hipStream_t stream) {
    static int grid = 0;
    if (grid == 0) {
        if (n_in != 14 || in_sizes[0] != MTOK * DM || out_size != MTOK * DM || ws_size < WS_END) { fprintf(stderr, "kernel_launch: unexpected shapes (n_in %d, in0 %d, out %d, ws %zu); nothing launched\n", n_in, n_in > 0 ? in_sizes[0] : -1, out_size, ws_size); grid = -1; return; }
        int dev = 0, cus = 0, per_cu = 0;
        if (hipGetDevice(&dev) != hipSuccess || hipDeviceGetAttribute(&cus, hipDeviceAttributeMultiprocessorCount, dev) != hipSuccess) { fprintf(stderr, "kernel_launch: device query failed\n"); grid = -1; return; }
        if (hipFuncSetAttribute((const void*)skel_fwd, hipFuncAttributeMaxDynamicSharedMemorySize, LDS_BYTES) != hipSuccess) { fprintf(stderr, "kernel_launch: hipFuncSetAttribute failed\n"); grid = -1; return; }
        if (hipOccupancyMaxActiveBlocksPerMultiprocessor(&per_cu, (const void*)skel_fwd, NWAVES * 64, LDS_BYTES) != hipSuccess || per_cu < 1) fprintf(stderr, "kernel_launch: occupancy query reports %d workgroups per CU\n", per_cu);
        (void)hipGetLastError();
        grid = cus;
    }
    if (grid < 0) return;
    (void)hipMemsetAsync((char*)d_ws + WS_CTL, 0, CTL_ZERO_BYTES, stream);
    Args a{};
    for (int i = 0; i < 14; ++i) a.in[i] = (const float*)d_in[i];
    a.out = (float*)d_out; a.ws = (unsigned char*)d_ws;
    for (int d = 0; d < 64; ++d) a.invf[d] = std::pow(10000.0, -(double)d / 64.0);
    for (int h = 0; h < 4; ++h) { const double gam = 1.0 - std::exp2(-5.0 - h), lgm = std::log(gam); a.lg[h] = (float)lgm; a.g1[h] = (float)gam; a.g127[h] = (float)std::exp(127.0 * lgm); a.g128[h] = (float)std::exp(128.0 * lgm); }
    if (N_LAUNCHES == 1) { a.ph_lo = 0; a.ph_hi = N_PHASES; hipLaunchKernelGGL(skel_fwd, dim3(grid), dim3(NWAVES * 64), LDS_BYTES, stream, a); }
    else for (int p = 0; p < N_PHASES; ++p) { a.ph_lo = p; a.ph_hi = p + 1; hipLaunchKernelGGL(skel_fwd, dim3(grid), dim3(NWAVES * 64), LDS_BYTES, stream, a); }
}
```

```cpp
#include <hip/hip_runtime.h>
#include <cstdio>
#include <cstdint>
#include <cmath>

#ifndef MK_N_LAUNCHES
#define MK_N_LAUNCHES 1
#endif
constexpr int N_PHASES = 9;
constexpr int N_LAUNCHES = MK_N_LAUNCHES;
static_assert(N_LAUNCHES == 1 || N_LAUNCHES == N_PHASES, "MK_N_LAUNCHES is 1 or 9");

namespace pg8 {
#define PG8_LAS __attribute__((address_space(3)))
typedef unsigned short bf16_t;
typedef short bf16x8 __attribute__((ext_vector_type(8)));
typedef float f32x4 __attribute__((ext_vector_type(4)));
typedef unsigned u32x4 __attribute__((ext_vector_type(4)));
typedef unsigned u32x2 __attribute__((ext_vector_type(2)));
constexpr int BM = 256, BK = 64, HALF = 128, HTB = HALF * BK * 2, STAGE_BYTES = 8 * HTB, NXCD = 8, WGM = 8;

__host__ __device__ __forceinline__ int lds_byte(int r, int c) { const int st = (r >> 4) * 2 + (c >> 5), rr = r & 15, cc = c & 31, ob = rr * 64 + cc * 2; return st * 1024 + (ob ^ (((ob >> 9) & 1) << 5)); }
__host__ __device__ __forceinline__ void stage_rc(int b, int& R, int& C) { const int st = b / 1024, sb = b % 1024, swz = sb ^ (((sb >> 9) & 1) << 5); R = (st >> 1) * 16 + swz / 64; C = (st & 1) * 32 + (swz % 64) / 2; }
__host__ __device__ __forceinline__ int perm32(int rho) { const int n = rho >> 4, i = rho & 15; return 8 * (i >> 2) + 4 * n + (i & 3); }

struct Unit { int pm, pn; };
struct Gemm { const bf16_t* A; const bf16_t* Bt; int M, N, K; };

template <int M_, int N_> struct StaticOrder {
    static constexpr int nM = M_ / BM, nN = N_ / BM, nwg = nM * nN;
    int G, c;
    __host__ __device__ void init(int G_, int c_) { G = G_; c = c_; }
    __host__ __device__ bool next(int i, Unit& u) const {
        const long L = (long)i * G + c; if (L >= nwg) return false;
        int wgid = (int)L; { const int q = nwg / NXCD, r = nwg % NXCD, xcd = wgid % NXCD, off = wgid / NXCD; wgid = (xcd < r ? xcd * (q + 1) : r * (q + 1) + (xcd - r) * q) + off; }
        static_assert(nM % WGM == 0 || nM < WGM, "row-tile groups are all the same size");
        constexpr int gsz = (nM < WGM) ? nM : WGM, nig = gsz * nN; const int gid = wgid / nig, fm = gid * gsz;
        u.pm = fm + ((wgid % nig) % gsz); u.pn = (wgid % nig) / gsz; return true;
    }
    __device__ __forceinline__ void a_ready(const Unit&) const {}
    __device__ __forceinline__ void done(const Unit&) const {}
};

typedef __bf16 bf16x2_t __attribute__((ext_vector_type(2)));
typedef float f32x2_t __attribute__((ext_vector_type(2)));
__device__ __forceinline__ unsigned cvt_pk_bf16(float lo, float hi) { const f32x2_t v = {lo, hi}; const bf16x2_t b = __builtin_convertvector(v, bf16x2_t); return __builtin_bit_cast(unsigned, b); }
__device__ __forceinline__ u32x4 pack8(const f32x4 a, const f32x4 b) { u32x4 w; w.x = cvt_pk_bf16(a[0], a[1]); w.y = cvt_pk_bf16(a[2], a[3]); w.z = cvt_pk_bf16(b[0], b[1]); w.w = cvt_pk_bf16(b[2], b[3]); return w; }
__device__ __forceinline__ float bf_lo(unsigned w) { return __uint_as_float(w << 16); }
__device__ __forceinline__ float bf_hi(unsigned w) { return __uint_as_float(w & 0xffff0000u); }

template <class Epi, class Sched, int K, bool ALIGN_EPI = false, bool SP2 = false>
__device__ __forceinline__ void gemm_phase(PG8_LAS unsigned char* lds, const Gemm g, const Sched& S, const Epi& E) {
    int tid = threadIdx.x; asm volatile("" : "+v"(tid));
    const int wid = __builtin_amdgcn_readfirstlane(tid >> 6), lane = tid & 63, wr = wid >> 2, wc = wid & 3, fr = lane & 15, fq = lane >> 4;
    constexpr int nt = K / BK;
    unsigned voffA[2], voffB[2];
#pragma unroll
    for (int i = 0; i < 2; ++i) { int R, C; stage_rc(tid * 16 + i * 8192, R, C); const int Rb = Epi::PERM ? ((R & ~31) + perm32(R & 31)) : R;
        voffA[i] = (unsigned)(R * K + C) * 2u; voffB[i] = (unsigned)(Rb * K + C) * 2u; }
    constexpr size_t kstep = (size_t)(BK * 2);
    constexpr size_t hstep = (size_t)HALF * K * 2;
    constexpr size_t tstep = 2 * hstep;
    const unsigned ldsw = (unsigned)wid * 1024u;
    const int aoff = lds_byte(wr * 64 + fr, fq * 8), boff = lds_byte(wc * 32 + fr, fq * 8);
#define PG8_SA(b, h) (((b) * 2 + (h)) * HTB)
#define PG8_SB(b, h) ((4 + (b) * 2 + (h)) * HTB)
#define PG8_STAGE(bufoff, gbase, voff) do { _Pragma("unroll") for (int _i = 0; _i < 2; ++_i) \
        __builtin_amdgcn_global_load_lds((const unsigned*)((const char*)(gbase) + (voff)[_i]), (PG8_LAS unsigned*)(lds + (bufoff) + ldsw + _i * 8192), 16, 0, 0); } while (0)
#define PG8_LDA(dst, b, h) do { _Pragma("unroll") for (int m = 0; m < 4; ++m) _Pragma("unroll") for (int k = 0; k < 2; ++k) dst[m][k] = *(const PG8_LAS bf16x8*)(lds + PG8_SA(b, h) + aoff + m * 2048 + k * 1024); } while (0)
#define PG8_LDB(dst, b, h) do { _Pragma("unroll") for (int n = 0; n < 2; ++n) _Pragma("unroll") for (int k = 0; k < 2; ++k) dst[n][k] = *(const PG8_LAS bf16x8*)(lds + PG8_SB(b, h) + boff + n * 2048 + k * 1024); } while (0)
#define PG8_MMA(ai, bj, At, Bt) do { __builtin_amdgcn_s_setprio(1); _Pragma("unroll") for (int m = 0; m < 4; ++m) _Pragma("unroll") for (int n = 0; n < 2; ++n) _Pragma("unroll") for (int k = 0; k < 2; ++k) \
        acc[ai][bj][m][n] = __builtin_amdgcn_mfma_f32_16x16x32_bf16(Bt[n][k], At[m][k], acc[ai][bj][m][n], 0, 0, 0); __builtin_amdgcn_s_setprio(0); } while (0)
#define PG8_WAIT_V(n) asm volatile("s_waitcnt vmcnt(" #n ")" ::: "memory")
#define PG8_WAIT_L(n) asm volatile("s_waitcnt lgkmcnt(" #n ")" ::: "memory")
#define PG8_BAR __builtin_amdgcn_s_barrier()
#define PG8_SCHED __builtin_amdgcn_sched_barrier(0)
    Unit cur, nxt; int ui = 0;
    if (!S.next(0, cur)) return;
    f32x4 acc[2][2][4][2];
#pragma unroll
    for (int a = 0; a < 2; ++a)
#pragma unroll
        for (int b = 0; b < 2; ++b)
#pragma unroll
            for (int m = 0; m < 4; ++m)
#pragma unroll
                for (int n = 0; n < 2; ++n) acc[a][b][m][n] = (f32x4){0.f, 0.f, 0.f, 0.f};
    bf16x8 At[4][2], B0[2][2], B1[2][2];
    const char* cA = (const char*)g.A + (size_t)cur.pm * tstep; const char* cB = (const char*)g.Bt + (size_t)cur.pn * tstep;
    S.a_ready(cur);
    if constexpr (SP2) {
        PG8_STAGE(PG8_SB(0, 0), cB, voffB); PG8_STAGE(PG8_SB(0, 1), cB + hstep, voffB); PG8_STAGE(PG8_SA(0, 0), cA, voffA); PG8_STAGE(PG8_SA(0, 1), cA + hstep, voffA);
        if (wr == 1) PG8_BAR;
        PG8_WAIT_V(2); PG8_BAR;
        PG8_STAGE(PG8_SB(1, 0), cB + kstep, voffB); PG8_STAGE(PG8_SA(1, 0), cA + kstep, voffA); PG8_STAGE(PG8_SB(1, 1), cB + hstep + kstep, voffB);
        PG8_WAIT_V(6); PG8_BAR;
    } else {
        PG8_STAGE(PG8_SB(0, 0), cB, voffB); PG8_STAGE(PG8_SA(0, 0), cA, voffA); PG8_STAGE(PG8_SB(0, 1), cB + hstep, voffB); PG8_STAGE(PG8_SA(0, 1), cA + hstep, voffA);
        if (wr == 1) PG8_BAR;
        PG8_WAIT_V(4); PG8_BAR;
        PG8_STAGE(PG8_SB(1, 0), cB + kstep, voffB); PG8_STAGE(PG8_SA(1, 0), cA + kstep, voffA); PG8_STAGE(PG8_SB(1, 1), cB + hstep + kstep, voffB);
        PG8_WAIT_V(6); PG8_BAR;
    }
    for (;;) {
        const bool has_next = S.next(ui + 1, nxt);
        const char* nA = has_next ? (const char*)g.A + (size_t)nxt.pm * tstep : cA; const char* nB = has_next ? (const char*)g.Bt + (size_t)nxt.pn * tstep : cB;
        for (int t = 0; t < nt; t += 2) {
            if constexpr (Epi::MID_T > 0) { if (t == Epi::MID_T) E.mid(acc, cur, wr, wc, fr, fq); }
            const bool last = (t == nt - 2);
            const char* a1 = cA + (size_t)(t + 1) * kstep;
            const char* a2 = last ? nA : cA + (size_t)(t + 2) * kstep; const char* b2 = last ? nB : cB + (size_t)(t + 2) * kstep;
            const char* a3 = a2 + kstep; const char* b3 = b2 + kstep;
            if (last && has_next) S.a_ready(nxt);
            if constexpr (SP2) {
            PG8_LDB(B0, 0, 0); PG8_LDB(B1, 0, 1); PG8_SCHED; PG8_LDA(At, 0, 0); PG8_STAGE(PG8_SA(1, 1), a1 + hstep, voffA);
            PG8_WAIT_V(8); PG8_WAIT_L(0); PG8_BAR; PG8_MMA(0, 0, At, B0); PG8_MMA(0, 1, At, B1); PG8_BAR; PG8_SCHED;
            PG8_LDA(At, 0, 1); PG8_STAGE(PG8_SB(0, 0), b2, voffB); PG8_STAGE(PG8_SB(0, 1), b2 + hstep, voffB); PG8_STAGE(PG8_SA(0, 0), a2, voffA);
            PG8_WAIT_V(8); PG8_WAIT_L(0); PG8_BAR; PG8_MMA(1, 0, At, B0); PG8_MMA(1, 1, At, B1); PG8_BAR; PG8_SCHED;
            PG8_LDB(B0, 1, 0); PG8_LDB(B1, 1, 1); PG8_SCHED; PG8_LDA(At, 1, 0); PG8_STAGE(PG8_SA(0, 1), a2 + hstep, voffA);
            PG8_WAIT_V(8); PG8_WAIT_L(0); PG8_BAR; PG8_MMA(0, 0, At, B0); PG8_MMA(0, 1, At, B1); PG8_BAR; PG8_SCHED;
            PG8_LDA(At, 1, 1); PG8_STAGE(PG8_SB(1, 0), b3, voffB); PG8_STAGE(PG8_SB(1, 1), b3 + hstep, voffB); PG8_STAGE(PG8_SA(1, 0), a3, voffA);
            PG8_WAIT_V(8); PG8_WAIT_L(0); PG8_BAR; PG8_MMA(1, 0, At, B0); PG8_MMA(1, 1, At, B1); PG8_BAR; PG8_SCHED;
            } else {
            PG8_LDB(B0, 0, 0); PG8_SCHED; PG8_LDA(At, 0, 0); PG8_STAGE(PG8_SA(1, 1), a1 + hstep, voffA);
            PG8_WAIT_L(8); PG8_BAR; PG8_WAIT_L(0); PG8_MMA(0, 0, At, B0); PG8_BAR; PG8_SCHED;
            PG8_LDB(B1, 0, 1); PG8_STAGE(PG8_SB(0, 0), b2, voffB);
            PG8_BAR; PG8_WAIT_L(0); PG8_MMA(0, 1, At, B1); PG8_BAR;
            PG8_LDA(At, 0, 1); PG8_STAGE(PG8_SA(0, 0), a2, voffA);
            PG8_BAR; PG8_WAIT_L(0); PG8_MMA(1, 0, At, B0); PG8_BAR; PG8_SCHED;
            PG8_STAGE(PG8_SB(0, 1), b2 + hstep, voffB);
            PG8_WAIT_V(6); PG8_BAR; PG8_MMA(1, 1, At, B1); PG8_BAR;
            PG8_LDB(B0, 1, 0); PG8_SCHED; PG8_LDA(At, 1, 0); PG8_STAGE(PG8_SA(0, 1), a2 + hstep, voffA);
            PG8_WAIT_L(8); PG8_BAR; PG8_WAIT_L(0); PG8_MMA(0, 0, At, B0); PG8_BAR; PG8_SCHED;
            PG8_LDB(B1, 1, 1); PG8_STAGE(PG8_SB(1, 0), b3, voffB);
            PG8_BAR; PG8_WAIT_L(0); PG8_MMA(0, 1, At, B1); PG8_BAR;
            PG8_LDA(At, 1, 1); PG8_STAGE(PG8_SA(1, 0), a3, voffA);
            PG8_BAR; PG8_WAIT_L(0); PG8_MMA(1, 0, At, B0); PG8_BAR; PG8_SCHED;
            PG8_STAGE(PG8_SB(1, 1), b3 + hstep, voffB);
            PG8_WAIT_V(6); PG8_BAR; PG8_MMA(1, 1, At, B1); PG8_BAR;
            }
        }
        if constexpr (ALIGN_EPI) { if (wr == 0) PG8_BAR; }
        E(acc, cur, wr, wc, fr, fq); S.done(cur);
        if (!has_next) break;
#pragma unroll
        for (int a = 0; a < 2; ++a)
#pragma unroll
            for (int b = 0; b < 2; ++b)
#pragma unroll
                for (int m = 0; m < 4; ++m)
#pragma unroll
                    for (int n = 0; n < 2; ++n) acc[a][b][m][n] = (f32x4){0.f, 0.f, 0.f, 0.f};
        cur = nxt; cA = nA; cB = nB; ++ui;
        if constexpr (ALIGN_EPI) { if (wr == 1) PG8_BAR; }
    }
    PG8_WAIT_V(0);
    if constexpr (!ALIGN_EPI) { if (wr == 0) PG8_BAR; }
    PG8_BAR;
#undef PG8_SA
#undef PG8_SB
#undef PG8_STAGE
#undef PG8_LDA
#undef PG8_LDB
#undef PG8_MMA
#undef PG8_WAIT_V
#undef PG8_WAIT_L
#undef PG8_BAR
#undef PG8_SCHED
}
}

#ifndef PG8_SP2
#define PG8_SP2 true
#endif
#ifndef PG8_ALIGN
#define PG8_ALIGN true
#endif

constexpr int NWAVES = 8;
constexpr int BATCH = 8, SEQ = 4096, DM = 1024, MTOK = BATCH * SEQ;
constexpr int NH = 4, DK = 128, DV = 256, QKW = 512, VW = 1024, CHUNK = 128, NCH = SEQ / CHUNK;
constexpr int PW = 512, DFF = 4096, INC = 5632;
constexpr int ZQ = 0, ZK = 512, ZV = 1024, ZG = 2048, ZPU = 3072, ZGT = 3584;
constexpr int N1 = 4608;
constexpr int M2 = 1536;
constexpr int K4 = 1536;
constexpr float EPS = 1e-6f;

constexpr size_t MiB = 1u << 20;
constexpr size_t WS_CTL = 0, CTL_ZERO_BYTES = 1 * MiB;
constexpr size_t WS_SS2 = 256 * 1024, WS_SS3 = 384 * 1024;
constexpr size_t WS_T1 = 2 * MiB;
constexpr size_t WS_T2C = 4 * MiB, WS_T2S = 5 * MiB;
constexpr size_t WS_DEC = 6 * MiB;
constexpr size_t WS_BT1 = 8 * MiB, WS_WT2 = 17 * MiB, WS_BT4 = 20 * MiB, WS_BT5 = 23 * MiB, WS_BT6 = 25 * MiB, WS_BT7 = 33 * MiB;
constexpr size_t WS_XN = 48 * MiB, WS_ST = 48 * MiB;
constexpr size_t WS_Q = 112 * MiB, WS_K = 144 * MiB, WS_KT = 176 * MiB, WS_VS = 208 * MiB, WS_SG = 272 * MiB, WS_PU = 336 * MiB, WS_GT = 368 * MiB;
constexpr size_t WS_MIX = 112 * MiB;
constexpr size_t WS_HID = 48 * MiB;
constexpr size_t WS_X1B = 304 * MiB, WS_X1 = 368 * MiB;
constexpr size_t WS_END = 496 * MiB;
static_assert(WS_BT7 + 8 * MiB <= WS_XN && WS_HID + 256 * MiB <= WS_X1B && WS_X1B + 64 * MiB <= WS_X1 && WS_X1 + 128 * MiB <= WS_END, "ws map");
constexpr int CW_TMO = 0, CW_CODE = 1, CW_BAR = 4096;
constexpr int RPITCH = K4;

constexpr int RING_OFF = 0, RING_BYTES = 131072;
constexpr int LDSCTL_OFF = RING_BYTES, MISC_OFF = LDSCTL_OFF + 320;
constexpr int LDS_BYTES = 147456;

#define GAS __attribute__((address_space(1)))
#define LAS __attribute__((address_space(3)))
typedef unsigned short bf16;
typedef unsigned v4u __attribute__((ext_vector_type(4)));
typedef unsigned v2u __attribute__((ext_vector_type(2)));
typedef float f32x4 __attribute__((ext_vector_type(4)));
typedef short bf16x8 __attribute__((ext_vector_type(8)));
typedef GAS unsigned gu32;
#define RLX_AGENT __ATOMIC_RELAXED, __HIP_MEMORY_SCOPE_AGENT
#define LDS_WAIT() asm volatile("s_waitcnt lgkmcnt(0)" ::: "memory")
#define VM_WAIT() asm volatile("s_waitcnt vmcnt(0)" ::: "memory")
__device__ __forceinline__ unsigned f2bf(float f) { unsigned u = __builtin_bit_cast(unsigned, f); return (u + 0x7fffu + ((u >> 16) & 1u)) >> 16; }
__device__ __forceinline__ unsigned pk2(float lo, float hi) { return f2bf(lo) | (f2bf(hi) << 16); }
using pg8::cvt_pk_bf16; using pg8::pack8; using pg8::bf_lo; using pg8::bf_hi;

#define XB_TMO      128
#define XB_XCNT(j)  (256  + 64 * (j))
#define XB_XSUB(j)  (1280 + 64 * (j))
#define XB_XGEN(j)  (2304 + 64 * (j))
#define XB_TOP      3328
#define XB_TOPGEN   3392
#define XCD_BAR_WORDS 3456
#define XB_SPIN_CAP (1u << 18)
__device__ __forceinline__ unsigned xb_ld(unsigned* p)              { return __hip_atomic_load(p, __ATOMIC_RELAXED, __HIP_MEMORY_SCOPE_AGENT); }
__device__ __forceinline__ unsigned xb_add(unsigned* p, unsigned v) { return __hip_atomic_fetch_add(p, v, __ATOMIC_RELAXED, __HIP_MEMORY_SCOPE_AGENT); }
__device__ __forceinline__ unsigned xb_xcc_id() { return (unsigned)__builtin_amdgcn_s_getreg((3 << 11) | 20) & 0xFu; }
#define XB_SPIN(cond, bar) do { unsigned _sp = 0; while (cond) { __builtin_amdgcn_s_sleep(1); \
    if ((++_sp & 255u) == 0u) { if (xb_ld(&(bar)[XB_TMO])) break; if (_sp > XB_SPIN_CAP) { atomicAdd(&(bar)[XB_TMO], 1u); break; } } } } while (0)
struct XcdBarrier { unsigned* bar; unsigned x; volatile LAS unsigned* st; };
__device__ __forceinline__ XcdBarrier xcd_barrier_post(unsigned* bar, volatile LAS unsigned* st) {
    XcdBarrier b; b.bar = bar; b.x = xb_xcc_id(); b.st = st;
    if (threadIdx.x == 0) (void)xb_add(&bar[XB_XCNT(b.x)], 1u);
    return b;
}
__device__ __forceinline__ void xcd_barrier_complete(unsigned* bar, unsigned x, unsigned& nloc, unsigned& nx) {
    const unsigned G = gridDim.x * gridDim.y * gridDim.z;
    unsigned sum, cnt, mine, sp = 0u;
    for (;;) {
        sum = 0u; cnt = 0u; mine = 0u;
#pragma unroll
        for (unsigned j = 0; j < 16; ++j) { const unsigned c = xb_ld(&bar[XB_XCNT(j)]); sum += c; cnt += (c > 0u) ? 1u : 0u; mine = (j == x) ? c : mine; }
        if (sum == G) break;
        __builtin_amdgcn_s_sleep(1);
        if ((++sp & 255u) == 0u) { if (xb_ld(&bar[XB_TMO])) break; if (sp > XB_SPIN_CAP) { atomicAdd(&bar[XB_TMO], 1u); break; } }
    }
    nloc = mine > 0u ? mine : 1u; nx = cnt > 0u ? cnt : 1u;
}
__device__ __forceinline__ void xcd_barrier(const XcdBarrier& b) {
    asm volatile("s_waitcnt vmcnt(0)" ::: "memory");
    __syncthreads();
    if (threadIdx.x == 0) {
        unsigned* bar = b.bar;
        __builtin_amdgcn_s_waitcnt(0);
        unsigned nloc = b.st[0], nx = b.st[1];
        if (nloc == 0u) { xcd_barrier_complete(bar, b.x, nloc, nx); b.st[0] = nloc; b.st[1] = nx; }
        const unsigned old = xb_add(&bar[XB_XSUB(b.x)], 1u);
        const unsigned gen = old / nloc;
        if (old + 1u == (gen + 1u) * nloc) {
            __builtin_amdgcn_fence(__ATOMIC_RELEASE, "agent");
            asm volatile("s_waitcnt vmcnt(0)" ::: "memory");
            const unsigned og = xb_add(&bar[XB_TOP], 1u);
            const unsigned tg = og / nx;
            if (og + 1u == (tg + 1u) * nx) xb_add(&bar[XB_TOPGEN], 1u);
            else XB_SPIN(xb_ld(&bar[XB_TOPGEN]) == tg, bar);
            __builtin_amdgcn_fence(__ATOMIC_ACQUIRE, "agent");
            xb_add(&bar[XB_XGEN(b.x)], 1u);
            asm volatile("s_waitcnt vmcnt(0)" ::: "memory");
        } else {
            XB_SPIN(xb_ld(&bar[XB_XGEN(b.x)]) == gen, bar);
            __builtin_amdgcn_fence(__ATOMIC_ACQUIRE, "agent");
            asm volatile("s_waitcnt vmcnt(0)" ::: "memory");
        }
    }
    __syncthreads();
}

struct Args {
    const float* in[14]; float* out; unsigned char* ws;
    double invf[64];
    float lg[4], g1[4], g127[4], g128[4];
    int ph_lo, ph_hi;
};
struct Frame {
    LAS unsigned char* lds; gu32* ctl;
    int tid, lane, wave, vcu, G;
    unsigned char* ws; float* out;
};
__device__ __forceinline__ float wave_sum(float v) {
#pragma unroll
    for (int o = 1; o < 64; o <<= 1) v += __shfl_xor(v, o);
    return v;
}

__device__ __forceinline__ void tr_item(const float* W, int ldw, int k0, int scol0, const float* kscale, bf16* WT, int dpitch, int drow0, LAS float* scr, int lane) {
#pragma unroll 8
    for (int i = 0; i < 32; ++i) { const int kk = 2 * i + (lane >> 5); float v = W[(size_t)(k0 + kk) * ldw + scol0 + (lane & 31)]; if (kscale) v *= kscale[k0 + kk]; scr[kk * 33 + (lane & 31)] = v; }
    LDS_WAIT(); asm volatile("" ::: "memory");
    const int c = lane & 7;
#pragma unroll
    for (int j = 0; j < 4; ++j) { const int n = (lane >> 3) + 8 * j; const LAS float* s = scr + (8 * c) * 33 + n;
        v4u o; o.x = pk2(s[0 * 33], s[1 * 33]); o.y = pk2(s[2 * 33], s[3 * 33]); o.z = pk2(s[4 * 33], s[5 * 33]); o.w = pk2(s[6 * 33], s[7 * 33]);
        *(GAS v4u*)(WT + (size_t)(drow0 + n) * dpitch + k0 + 8 * c) = o; }
    LDS_WAIT(); asm volatile("" ::: "memory");
}
__device__ __forceinline__ int bt1_src_col(int p0) {
    if (p0 < 1024) { const int pn = p0 >> 8, pp = p0 & 255, bj = pp >> 7, hh = (pp >> 6) & 1, dd0 = pp & 63; return (pn >> 1) * 512 + (pn & 1) * 256 + 128 * hh + 64 * bj + dd0; }
    if (p0 < 2048) return ZG + (p0 - 1024);
    if (p0 < 2560) return ZPU + (p0 - 2048);
    return ZGT + (p0 - 2560);
}
__device__ __forceinline__ int wt2_src_col(int r0) {
    if (r0 < 512) { const int pm = r0 >> 8, rr = r0 & 255, ai = rr >> 7, hh = (rr >> 6) & 1, dd0 = rr & 63; return ZK + pm * 256 + 128 * hh + 64 * ai + dd0; }
    return ZV + (r0 - 512);
}
__device__ __forceinline__ void sincos_d(double ang, float& c, float& s) {
    const double TWO_PI = 6.283185307179586476925286766559, TWO_PI_LO = 2.4492935982947064e-16, INV = 0.15915494309189533576888376337251;
    const double k = __builtin_rint(ang * INV); double r = __builtin_fma(-k, TWO_PI, ang);
    r = __builtin_fma(-k, TWO_PI_LO, r);
    const double HPI = 1.5707963267948966192313216916398;
    const double qd = __builtin_rint(r / HPI); const int qi = (int)qd; const double y = r - qd * HPI;
    const double y2 = y * y;
    double sp = -1.0 / 1307674368000.0; sp = sp * y2 + 1.0 / 6227020800.0; sp = sp * y2 - 1.0 / 39916800.0; sp = sp * y2 + 1.0 / 362880.0; sp = sp * y2 - 1.0 / 5040.0; sp = sp * y2 + 1.0 / 120.0; sp = sp * y2 - 1.0 / 6.0; sp = sp * y2 * y + y;
    double cp = 1.0 / 87178291200.0; cp = cp * y2 - 1.0 / 479001600.0; cp = cp * y2 + 1.0 / 3628800.0; cp = cp * y2 - 1.0 / 40320.0; cp = cp * y2 + 1.0 / 720.0; cp = cp * y2 - 1.0 / 24.0; cp = cp * y2 + 0.5; cp = 1.0 - cp * y2;
    double sv, cv;
    switch (qi & 3) { case 0: sv = sp; cv = cp; break; case 1: sv = cp; cv = -sp; break; case 2: sv = -sp; cv = -cp; break; default: sv = -cp; cv = sp; break; }
    c = (float)cv; s = (float)sv;
}
__device__ __forceinline__ void p0_prologue(Frame& F, const __attribute__((address_space(4))) Args* Ap) {
    const __attribute__((address_space(4))) Args& A = *Ap;
    const float* x = A.in[0]; const float* ln_mix = A.in[1]; const float* w_in = A.in[2]; const float* gn_gain = A.in[4]; const float* w_ret_up = A.in[5];
    const float* pool_w = A.in[6]; const float* pool_scale = A.in[7]; const float* w_pool_up = A.in[8]; const float* w_o = A.in[9]; const float* ln_mlp = A.in[10];
    const float* w_up = A.in[11]; const float* w_down = A.in[12];
    bf16* BT1 = (bf16*)(F.ws + WS_BT1); bf16* WT2 = (bf16*)(F.ws + WS_WT2); bf16* BT4 = (bf16*)(F.ws + WS_BT4); bf16* BT5 = (bf16*)(F.ws + WS_BT5); bf16* BT6 = (bf16*)(F.ws + WS_BT6); bf16* BT7 = (bf16*)(F.ws + WS_BT7);
    LAS float* scr = (LAS float*)(F.lds + RING_OFF + F.wave * 16384);
    const int gw = F.vcu * NWAVES + F.wave, NGW = F.G * NWAVES;
    constexpr int I1 = 16 * (N1 / 32), I2 = 16 * (M2 / 32), I4 = 16 * 32, I5 = 16 * 32, I6 = 16 * (DFF / 32), I7 = 64 * 32;
    constexpr int NITEMS = I1 + I2 + I4 + I5 + I6 + I7;
    for (int it = gw; it < NITEMS; it += NGW) {
        int r = it;
        if (r < I1) { const int nb = r % (N1 / 32), kb = r / (N1 / 32); tr_item(w_in, INC, 64 * kb, bt1_src_col(32 * nb), ln_mix, BT1, DM, 32 * nb, scr, F.lane); continue; } r -= I1;
        if (r < I2) { const int nb = r % (M2 / 32), kb = r / (M2 / 32); tr_item(w_in, INC, 64 * kb, wt2_src_col(32 * nb), ln_mix, WT2, DM, 32 * nb, scr, F.lane); continue; } r -= I2;
        if (r < I4) { const int nb = r % 32, kb = r / 32; tr_item(w_ret_up, DM, 64 * kb, 32 * nb, gn_gain, BT4, K4, 32 * nb, scr, F.lane); continue; } r -= I4;
        if (r < I5) { const int nb = r % 32, kb = r / 32; tr_item(w_o, DM, 64 * kb, 32 * nb, nullptr, BT5, DM, 32 * nb, scr, F.lane); continue; } r -= I5;
        if (r < I6) { const int nb = r % (DFF / 32), kb = r / (DFF / 32); tr_item(w_up, DFF, 64 * kb, 32 * nb, ln_mlp, BT6, DM, 32 * nb, scr, F.lane); continue; } r -= I6;
        { const int nb = r % 32, kb = r / 32; tr_item(w_down, DM, 64 * kb, 32 * nb, nullptr, BT7, DFF, 32 * nb, scr, F.lane); }
    }
    for (int it = gw; it < 4 * 16 * 16; it += NGW) {
        const int g = it >> 8, cb = (it >> 4) & 15, nb = it & 15, n = nb * 64 + F.lane, c0 = cb * 8;
        float a[8];
#pragma unroll
        for (int i = 0; i < 8; ++i) a[i] = 0.f;
        for (int j = 0; j < 128; ++j) {
            const float w = w_pool_up[(size_t)(g * 128 + j) * DM + n] * pool_scale[g * 128 + j];
#pragma unroll
            for (int i = 0; i < 8; ++i) a[i] += pool_w[(size_t)(g * 128 + c0 + i) * 128 + j] * w;
        }
        v4u o; o.x = pk2(a[0], a[1]); o.y = pk2(a[2], a[3]); o.z = pk2(a[4], a[5]); o.w = pk2(a[6], a[7]);
        *(GAS v4u*)(BT4 + (size_t)n * K4 + 1024 + g * 128 + c0) = o;
    }
    bf16* XN = (bf16*)(F.ws + WS_XN);
    for (int m = gw; m < MTOK; m += NGW) {
        const GAS f32x4* xr = (const GAS f32x4*)(x + (size_t)m * DM) + F.lane;
        f32x4 v[4]; float s = 0.f;
#pragma unroll
        for (int j = 0; j < 4; ++j) { v[j] = xr[64 * j]; s += (v[j].x * v[j].x + v[j].y * v[j].y) + (v[j].z * v[j].z + v[j].w * v[j].w); }
        const float rstd = 1.f / sqrtf(wave_sum(s) * (1.f / DM) + EPS);
        GAS unsigned long long* o8 = (GAS unsigned long long*)(XN + (size_t)m * DM) + F.lane;
#pragma unroll
        for (int j = 0; j < 4; ++j) o8[64 * j] = (unsigned long long)pk2(v[j].x * rstd, v[j].y * rstd) | ((unsigned long long)pk2(v[j].z * rstd, v[j].w * rstd) << 32);
    }
    float* T1 = (float*)(F.ws + WS_T1); float* T2C = (float*)(F.ws + WS_T2C); float* T2S = (float*)(F.ws + WS_T2S); float* DEC = (float*)(F.ws + WS_DEC);
    const int gt = F.vcu * NWAVES * 64 + F.tid, NGT = F.G * NWAVES * 64;
    for (int i = gt; i < SEQ * 64; i += NGT) {
        const int pos = i >> 6, dd = i & 63; float c, s; sincos_d((double)pos * A.invf[dd], c, s);
        T1[pos * 128 + dd] = c; T1[pos * 128 + 64 + dd] = s; T2C[dd * SEQ + pos] = c; T2S[dd * SEQ + pos] = s;
    }
    if (gt < 512) { const int h = gt >> 7, m = gt & 127; DEC[gt] = expf(-(float)m * A.lg[h]); }
}

struct EpiIn {
    static constexpr bool PERM = true; static constexpr int MID_T = 0;
    unsigned char* ws; const float* bgate;
    __device__ __forceinline__ void operator()(const f32x4 (&acc)[2][2][4][2], const pg8::Unit& u, int wr, int wc, int fr, int fq) const {
        const int row0 = u.pm * 256 + wr * 64 + fr;
        bf16* const SG = (bf16*)(ws + WS_SG); bf16* const PU = (bf16*)(ws + WS_PU); bf16* const GT = (bf16*)(ws + WS_GT); const float* const T1 = (const float*)(ws + WS_T1);
        if (u.pn < 4) {
            bf16* dst = (bf16*)(ws + ((u.pn < 2) ? WS_Q : WS_K)); const float sc = (u.pn < 2) ? 0.08838834764831845f : 1.0f;
            const int head = 2 * (u.pn & 1) + (wc >> 1), dd0 = 32 * (wc & 1) + 8 * fq;
#pragma unroll
            for (int ai = 0; ai < 2; ++ai)
#pragma unroll
                for (int m = 0; m < 4; ++m) {
                    const int row = row0 + ai * 128 + m * 16; const float* t = T1 + (size_t)(row & (SEQ - 1)) * 128 + dd0;
                    const f32x4 c0 = *(const f32x4*)t, c1 = *(const f32x4*)(t + 4), s0 = *(const f32x4*)(t + 64), s1 = *(const f32x4*)(t + 68);
                    const f32x4 a0 = acc[ai][0][m][0], a1 = acc[ai][0][m][1], b0 = acc[ai][1][m][0], b1 = acc[ai][1][m][1];
                    const f32x4 o10 = (a0 * c0 - b0 * s0) * sc, o11 = (a1 * c1 - b1 * s1) * sc, o20 = (a0 * s0 + b0 * c0) * sc, o21 = (a1 * s1 + b1 * c1) * sc;
                    bf16* p = dst + (size_t)row * QKW + head * 128 + dd0;
                    *(v4u*)p = pack8(o10, o11); *(v4u*)(p + 64) = pack8(o20, o21);
                    if (m & 1) asm volatile("" ::: "memory");
                }
        } else if (u.pn < 8) {
            const int col0 = (u.pn - 4) * 256 + wc * 32 + 8 * fq;
#pragma unroll
            for (int ai = 0; ai < 2; ++ai)
#pragma unroll
                for (int m = 0; m < 4; ++m)
#pragma unroll
                    for (int bj = 0; bj < 2; ++bj) {
                        f32x4 v[2];
#pragma unroll
                        for (int n = 0; n < 2; ++n)
#pragma unroll
                            for (int j = 0; j < 4; ++j) { const float a = acc[ai][bj][m][n][j]; v[n][j] = a * __builtin_amdgcn_rcpf(1.0f + __expf(-a)); }
                        *(v4u*)(SG + (size_t)(row0 + ai * 128 + m * 16) * VW + col0 + bj * 128) = pack8(v[0], v[1]);
                    }
        } else if (u.pn < 10) {
            const int col0 = (u.pn - 8) * 256 + wc * 32 + 8 * fq;
#pragma unroll
            for (int ai = 0; ai < 2; ++ai)
#pragma unroll
                for (int m = 0; m < 4; ++m)
#pragma unroll
                    for (int bj = 0; bj < 2; ++bj) *(v4u*)(PU + (size_t)(row0 + ai * 128 + m * 16) * PW + col0 + bj * 128) = pack8(acc[ai][bj][m][0], acc[ai][bj][m][1]);
        } else {
            const int col0 = (u.pn - 10) * 256 + wc * 32 + 8 * fq;
            f32x4 bv[2][2];
#pragma unroll
            for (int bj = 0; bj < 2; ++bj)
#pragma unroll
                for (int n = 0; n < 2; ++n) bv[bj][n] = *(const f32x4*)(bgate + col0 + bj * 128 + 4 * n);
#pragma unroll
            for (int ai = 0; ai < 2; ++ai)
#pragma unroll
                for (int m = 0; m < 4; ++m)
#pragma unroll
                    for (int bj = 0; bj < 2; ++bj) {
                        f32x4 v[2];
#pragma unroll
                        for (int n = 0; n < 2; ++n)
#pragma unroll
                            for (int j = 0; j < 4; ++j) { const float a = acc[ai][bj][m][n][j] + bv[bj][n][j]; v[n][j] = __builtin_amdgcn_rcpf(1.0f + __expf(-a)); }
                        *(v4u*)(GT + (size_t)(row0 + ai * 128 + m * 16) * 2048 + col0 + bj * 128) = pack8(v[0], v[1]);
                    }
        }
    }
};
struct EpiInT {
    static constexpr bool PERM = true; static constexpr int MID_T = 0;
    unsigned char* ws;
    __device__ __forceinline__ void operator()(const f32x4 (&acc)[2][2][4][2], const pg8::Unit& u, int wr, int wc, int fr, int fq) const {
        const int tok0 = u.pn * 256 + wc * 32 + 8 * fq;
        if (u.pm < 2) {
            GAS unsigned char* const KT = (GAS unsigned char*)(ws + WS_KT); const GAS unsigned char* const T2C = (const GAS unsigned char*)(ws + WS_T2C); const GAS unsigned char* const T2S = (const GAS unsigned char*)(ws + WS_T2S);
            const int head = 2 * u.pm + wr;
#pragma unroll
            for (int m = 0; m < 4; ++m) {
                const int dd = 16 * m + fr;
#pragma unroll
                for (int bj = 0; bj < 2; ++bj) {
                    const int tok = tok0 + bj * 128, pos = tok & (SEQ - 1);
                    const unsigned toff = (unsigned)(dd * SEQ + pos) * 4u;
                    const f32x4 c0 = *(const GAS f32x4*)(T2C + toff), c1 = *(const GAS f32x4*)(T2C + toff + 16), s0 = *(const GAS f32x4*)(T2S + toff), s1 = *(const GAS f32x4*)(T2S + toff + 16);
                    const f32x4 a0 = acc[0][bj][m][0], a1 = acc[0][bj][m][1], b0 = acc[1][bj][m][0], b1 = acc[1][bj][m][1];
                    const unsigned koff = (unsigned)((((tok >> 7) * NH + head) * 128 + dd) * 128 + (tok & 127)) * 2u;
                    *(GAS v4u*)(KT + koff) = pack8(a0 * c0 - b0 * s0, a1 * c1 - b1 * s1);
                    *(GAS v4u*)(KT + koff + (unsigned)(64 * 128 * 2)) = pack8(a0 * s0 + b0 * c0, a1 * s1 + b1 * c1);
                    asm volatile("" ::: "memory");
                }
            }
        } else {
            GAS unsigned char* const VS = (GAS unsigned char*)(ws + WS_VS); const GAS float* const DEC = (const GAS float*)(ws + WS_DEC);
            const int head = u.pm - 2; const GAS float* d = DEC + head * 128 + wc * 32 + 8 * fq;
            const f32x4 d0 = *(const GAS f32x4*)d, d1 = *(const GAS f32x4*)(d + 4);
#pragma unroll
            for (int ai = 0; ai < 2; ++ai)
#pragma unroll
                for (int m = 0; m < 4; ++m) {
#pragma unroll
                    for (int bj = 0; bj < 2; ++bj)
                        *(GAS v4u*)(VS + (unsigned)(((((tok0 >> 7) + bj) * NH + head) * 256 + ai * 128 + wr * 64 + m * 16 + fr) * 128 + (tok0 & 127)) * 2u) = pack8(acc[ai][bj][m][0] * d0, acc[ai][bj][m][1] * d1);
                    asm volatile("" ::: "memory");
                }
        }
    }
};

__device__ __forceinline__ void p2_scan(Frame& F, const __attribute__((address_space(4))) Args* Ap) {
    const __attribute__((address_space(4))) Args& A = *Ap;
    const unsigned char* KT = (const unsigned char*)(F.ws + WS_KT); const unsigned char* VS = (const unsigned char*)(F.ws + WS_VS); bf16* ST = (bf16*)(F.ws + WS_ST);
    const int r = F.lane & 15, q = F.lane >> 4, w = F.wave;
    LAS unsigned char* ring = F.lds + RING_OFF;
    constexpr int BUFB = 40960;
    unsigned gV[4];
#pragma unroll
    for (int k = 0; k < 4; ++k) { const int row = (k * 8 + w) * 4 + (F.lane >> 4), pc = F.lane & 15; gV[k] = (unsigned)(row * 256 + ((pc ^ (row & 15)) << 4)); }
    unsigned xo[4];
#pragma unroll
    for (int ks = 0; ks < 4; ++ks) xo[ks] = (unsigned)(((4 * ks + q) ^ r) << 4);
    for (int item = F.vcu; item < BATCH * NH * 8; item += F.G) {
        const int bh = item >> 3, es = item & 7, b = bh >> 2, h = bh & 3, e0 = 32 * es + 16 * (w >> 2), d0 = 32 * (w & 3);
        const unsigned char* ktb = KT + (size_t)((b * NCH) * NH + h) * 32768; const unsigned char* vsb = VS + (size_t)((b * NCH) * NH + h) * 65536 + (size_t)(32 * es) * 256;
#define P2_STAGE(n_, bi_) do { const unsigned char* kp_ = ktb + (size_t)(n_) * (NH * 32768); LAS unsigned char* lb_ = ring + (bi_) * BUFB; \
        _Pragma("unroll") for (int k_ = 0; k_ < 4; ++k_) __builtin_amdgcn_global_load_lds((const unsigned*)(kp_ + gV[k_]), (LAS unsigned*)(lb_ + (k_ * 8 + w) * 1024), 16, 0, 0); \
        __builtin_amdgcn_global_load_lds((const unsigned*)(vsb + (size_t)(n_) * (NH * 65536) + gV[0]), (LAS unsigned*)(lb_ + 32768 + w * 1024), 16, 0, 0); } while (0)
        const float g1 = A.g1[h], g127 = A.g127[h], g128 = A.g128[h];
        f32x4 s0 = {0.f, 0.f, 0.f, 0.f}, s1 = {0.f, 0.f, 0.f, 0.f};
        P2_STAGE(0, 0); P2_STAGE(1, 1);
        int bi = 0;
        for (int n = 0; n < NCH; ++n) {
            asm volatile("s_waitcnt vmcnt(5)" ::: "memory");
            __builtin_amdgcn_s_barrier(); asm volatile("" ::: "memory");
            bf16* sp = ST + ((size_t)(((b * NCH + n) * NH + h) * 256 + e0 + r)) * 128 + d0 + 4 * q;
            { v2u o; o.x = cvt_pk_bf16(s0[0] * g1, s0[1] * g1); o.y = cvt_pk_bf16(s0[2] * g1, s0[3] * g1); *(v2u*)sp = o;
              o.x = cvt_pk_bf16(s1[0] * g1, s1[1] * g1); o.y = cvt_pk_bf16(s1[2] * g1, s1[3] * g1); *(v2u*)(sp + 16) = o; }
            asm volatile("" ::: "memory");
            { const int nn = (n + 2 < NCH) ? n + 2 : NCH - 1; const int b2 = (bi + 2 >= 3) ? bi - 1 : bi + 2; P2_STAGE(nn, b2); }
            const LAS unsigned char* kb = ring + bi * BUFB + (d0 + r) * 256; const LAS unsigned char* vb = ring + bi * BUFB + 32768 + (16 * (w >> 2) + r) * 256;
            f32x4 c0 = {0.f, 0.f, 0.f, 0.f}, c1 = {0.f, 0.f, 0.f, 0.f};
#pragma unroll
            for (int ks = 0; ks < 4; ++ks) { const bf16x8 a0 = *(const LAS bf16x8*)(kb + xo[ks]), a1 = *(const LAS bf16x8*)(kb + 16 * 256 + xo[ks]), bb = *(const LAS bf16x8*)(vb + xo[ks]);
                c0 = __builtin_amdgcn_mfma_f32_16x16x32_bf16(a0, bb, c0, 0, 0, 0); c1 = __builtin_amdgcn_mfma_f32_16x16x32_bf16(a1, bb, c1, 0, 0, 0); }
            s0 = s0 * g128 + c0 * g127; s1 = s1 * g128 + c1 * g127;
            bi = (bi == 2) ? 0 : bi + 1;
        }
        asm volatile("s_waitcnt vmcnt(0)" ::: "memory"); __builtin_amdgcn_s_barrier(); asm volatile("" ::: "memory");
#undef P2_STAGE
    }
}

struct PoolItem { v4u u0; v4u v[16]; int t, col0, pos; };
__device__ __forceinline__ void pool_issue(PoolItem& P, const bf16* PU, int it, int lane) {
    const int g = it & 3, W = 2 << g; P.t = (it >> 2) * 4 + (lane >> 4); P.col0 = g * 128 + 8 * (lane & 15); P.pos = P.t & (SEQ - 1);
    P.u0 = *(const v4u*)(PU + (size_t)P.t * PW + P.col0);
#pragma unroll
    for (int j = 0; j < 16; ++j) if (j < W) { const int tj = (j <= P.pos) ? P.t - j : P.t; P.v[j] = *(const v4u*)(PU + (size_t)tj * PW + P.col0); }
}
__device__ __forceinline__ void pool_finish(const PoolItem& P, bf16* RGP, int it) {
    const int g = it & 3, W = 2 << g;
    float s[8];
#pragma unroll
    for (int k = 0; k < 8; ++k) s[k] = 0.f;
#pragma unroll
    for (int j = 0; j < 16; ++j) if (j < W) { const float wj = (j <= P.pos) ? 1.0f : 0.0f; const v4u v = P.v[j];
        s[0] += wj * bf_lo(v.x); s[1] += wj * bf_hi(v.x); s[2] += wj * bf_lo(v.y); s[3] += wj * bf_hi(v.y); s[4] += wj * bf_lo(v.z); s[5] += wj * bf_hi(v.z); s[6] += wj * bf_lo(v.w); s[7] += wj * bf_hi(v.w); }
    const int cnt = (P.pos + 1 < W) ? P.pos + 1 : W; const float ic = 1.0f / (float)cnt; const v4u u0 = P.u0;
    v4u o; o.x = pk2(s[0] * ic - bf_lo(u0.x), s[1] * ic - bf_hi(u0.x)); o.y = pk2(s[2] * ic - bf_lo(u0.y), s[3] * ic - bf_hi(u0.y));
    o.z = pk2(s[4] * ic - bf_lo(u0.z), s[5] * ic - bf_hi(u0.z)); o.w = pk2(s[6] * ic - bf_lo(u0.w), s[7] * ic - bf_hi(u0.w));
    *(v4u*)(RGP + (size_t)P.t * RPITCH + 1024 + P.col0) = o;
}

__device__ __forceinline__ void p3_retention(Frame& F, const __attribute__((address_space(4))) Args* Ap) {
    const __attribute__((address_space(4))) Args& A = *Ap;
    const bf16* Q = (const bf16*)(F.ws + WS_Q); const unsigned char* Kb = (const unsigned char*)(F.ws + WS_K); const unsigned char* VS = (const unsigned char*)(F.ws + WS_VS); const unsigned char* ST = (const unsigned char*)(F.ws + WS_ST);
    const bf16* SG = (const bf16*)(F.ws + WS_SG); bf16* RGP = (bf16*)F.out;
    const int r = F.lane & 15, q = F.lane >> 4, w = F.wave;
    LAS unsigned char* ring = F.lds + RING_OFF;
    unsigned gK[4], gV[4];
#pragma unroll
    for (int k = 0; k < 4; ++k) { const int row = (k * 8 + w) * 4 + (F.lane >> 4), pc = F.lane & 15;
        gK[k] = (unsigned)(row * 1024 + ((pc ^ ((row & 3) | (((row >> 3) & 3) << 2))) << 4)); gV[k] = (unsigned)(row * 256 + ((pc ^ (row & 15)) << 4)); }
    const unsigned rK = (unsigned)(8 * (r >> 2) + (r & 3)) * 256u, rV = (unsigned)r * 256u; unsigned xo[4];
#pragma unroll
    for (int ks = 0; ks < 4; ++ks) xo[ks] = (unsigned)(((4 * ks + q) ^ r) << 4);
#define P3_STAGE(slot, gbase, goff) do { _Pragma("unroll") for (int k_ = 0; k_ < 4; ++k_) \
        __builtin_amdgcn_global_load_lds((const unsigned*)((const unsigned char*)(gbase) + (goff)[k_]), (LAS unsigned*)(ring + (slot) * 32768 + (k_ * 8 + w) * 1024), 16, 0, 0); } while (0)
#define P3_SYNC() do { asm volatile("s_waitcnt vmcnt(0)" ::: "memory"); __builtin_amdgcn_s_barrier(); asm volatile("" ::: "memory"); } while (0)
    const int cl = 16 * w + r, nks = ((16 * w + 15) >> 5) + 1;
    const bf16* PU = (const bf16*)(F.ws + WS_PU); const int gw = F.vcu * NWAVES + w, NGW = F.G * NWAVES; int pit = gw;
    PoolItem PI;
    int sp = 0;
    int unit = F.vcu;
    if (unit >= BATCH * NCH * NH) return;
    bf16x8 qf[4];
    { const int h = unit & 3, n = (unit >> 2) & 31, b = unit >> 7, tok0 = b * SEQ + n * CHUNK;
      P3_STAGE(sp & 3, Kb + ((size_t)tok0 * QKW + h * 128) * 2, gK);
#pragma unroll
      for (int ks = 0; ks < 4; ++ks) qf[ks] = *(const bf16x8*)(Q + (size_t)(tok0 + cl) * QKW + h * 128 + 32 * ks + 8 * q); }
    for (; unit < BATCH * NCH * NH; unit += F.G) {
        const int h = unit & 3, n = (unit >> 2) & 31, b = unit >> 7, tok0 = b * SEQ + n * CHUNK;
        const int sA = sp & 3, sB0 = (sp + 1) & 3, sB1 = (sp + 2) & 3, sC0 = (sp + 3) & 3, sC1 = (sp + 4) & 3; sp += 5;
        const unsigned char* vsb = VS + (size_t)((b * NCH + n) * NH + h) * 65536; const unsigned char* stb = ST + (size_t)((b * NCH + n) * NH + h) * 65536;
        P3_SYNC();
        P3_STAGE(sB0, vsb, gV); P3_STAGE(sB1, stb, gV);
        bool pl = pit < MTOK; if (pl) pool_issue(PI, PU, pit, F.lane);
        bf16x8 pf[4];
#pragma unroll
        for (int k2 = 0; k2 < 4; ++k2) {
            v4u pw = {0u, 0u, 0u, 0u};
            if (k2 < nks) {
                f32x4 sa = {0.f, 0.f, 0.f, 0.f}, sb = {0.f, 0.f, 0.f, 0.f};
                const LAS unsigned char* kp = ring + sA * 32768 + (32 * k2) * 256 + rK;
#pragma unroll
                for (int ks = 0; ks < 4; ++ks) {
                    const bf16x8 ka = *(const LAS bf16x8*)(kp + xo[ks]), kb = *(const LAS bf16x8*)(kp + 4 * 256 + xo[ks]);
                    sa = __builtin_amdgcn_mfma_f32_16x16x32_bf16(ka, qf[ks], sa, 0, 0, 0); sb = __builtin_amdgcn_mfma_f32_16x16x32_bf16(kb, qf[ks], sb, 0, 0, 0);
                }
                const int mb = 32 * k2 + 8 * q;
#pragma unroll
                for (int i = 0; i < 4; ++i) { if (mb + i > cl) sa[i] = 0.f; if (mb + 4 + i > cl) sb[i] = 0.f; }
                pw.x = cvt_pk_bf16(sa[0], sa[1]); pw.y = cvt_pk_bf16(sa[2], sa[3]); pw.z = cvt_pk_bf16(sb[0], sb[1]); pw.w = cvt_pk_bf16(sb[2], sb[3]);
            }
            pf[k2] = __builtin_bit_cast(bf16x8, pw);
        }
        if (pl) { pool_finish(PI, RGP, pit); pit += NGW; }
        f32x4 acc[16];
#pragma unroll
        for (int g = 0; g < 16; ++g) acc[g] = (f32x4){0.f, 0.f, 0.f, 0.f};
        const int nxt = unit + F.G; const bool has_next = nxt < BATCH * NCH * NH;
#pragma unroll
        for (int hf = 0; hf < 2; ++hf) {
            P3_SYNC();
            if (hf == 0) { P3_STAGE(sC0, vsb + 32768, gV); P3_STAGE(sC1, stb + 32768, gV); }
            else if (has_next) { const int h2 = nxt & 3, n2 = (nxt >> 2) & 31, b2 = nxt >> 7, t2 = b2 * SEQ + n2 * CHUNK;
                P3_STAGE(sp & 3, Kb + ((size_t)t2 * QKW + h2 * 128) * 2, gK); }
            pl = pit < MTOK; if (pl) pool_issue(PI, PU, pit, F.lane);
            const LAS unsigned char* vp = ring + (hf == 0 ? sB0 : sC0) * 32768 + rV; const LAS unsigned char* spp = ring + (hf == 0 ? sB1 : sC1) * 32768 + rV;
#pragma unroll
            for (int ks = 0; ks < 4; ++ks) {
                if (ks < nks) {
#pragma unroll
                    for (int g = 0; g < 8; ++g) { const bf16x8 vf = *(const LAS bf16x8*)(vp + g * 4096 + xo[ks]); acc[8 * hf + g] = __builtin_amdgcn_mfma_f32_16x16x32_bf16(vf, pf[ks], acc[8 * hf + g], 0, 0, 0); }
                }
            }
#pragma unroll
            for (int ks = 0; ks < 4; ++ks)
#pragma unroll
                for (int g = 0; g < 8; ++g) { const bf16x8 sf = *(const LAS bf16x8*)(spp + g * 4096 + xo[ks]); acc[8 * hf + g] = __builtin_amdgcn_mfma_f32_16x16x32_bf16(sf, qf[ks], acc[8 * hf + g], 0, 0, 0); }
            if (pl) { pool_finish(PI, RGP, pit); pit += NGW; }
        }
        v2u gv[16];
        { const bf16* gp = SG + (size_t)(tok0 + cl) * VW + h * 256 + 4 * q;
#pragma unroll
          for (int g = 0; g < 16; ++g) gv[g] = *(const v2u*)(gp + 16 * g); }
        if (has_next) { const int h2 = nxt & 3, n2 = (nxt >> 2) & 31, b2 = nxt >> 7, t2 = b2 * SEQ + n2 * CHUNK;
#pragma unroll
            for (int ks = 0; ks < 4; ++ks) qf[ks] = *(const bf16x8*)(Q + (size_t)(t2 + cl) * QKW + h2 * 128 + 32 * ks + 8 * q); }
        pl = pit < MTOK; if (pl) pool_issue(PI, PU, pit, F.lane);
        const float rs = __expf((float)cl * A.lg[h]);
        float sm = 0.f;
#pragma unroll
        for (int g = 0; g < 16; ++g) { acc[g] = acc[g] * rs; sm += (acc[g][0] + acc[g][1]) + (acc[g][2] + acc[g][3]); }
        sm += __shfl_xor(sm, 16); sm += __shfl_xor(sm, 32);
        const float mu = sm * (1.0f / 256.0f); float v = 0.f;
#pragma unroll
        for (int g = 0; g < 16; ++g) { acc[g] = acc[g] - mu; v += (acc[g][0] * acc[g][0] + acc[g][1] * acc[g][1]) + (acc[g][2] * acc[g][2] + acc[g][3] * acc[g][3]); }
        v += __shfl_xor(v, 16); v += __shfl_xor(v, 32);
        const float rstd = 1.0f / sqrtf(v * (1.0f / 256.0f) + EPS);
        bf16* op = RGP + (size_t)(tok0 + cl) * RPITCH + h * 256 + 4 * q;
#pragma unroll
        for (int g = 0; g < 16; ++g) {
            v2u o; o.x = cvt_pk_bf16(acc[g][0] * rstd * bf_lo(gv[g].x), acc[g][1] * rstd * bf_hi(gv[g].x)); o.y = cvt_pk_bf16(acc[g][2] * rstd * bf_lo(gv[g].y), acc[g][3] * rstd * bf_hi(gv[g].y));
            *(v2u*)(op + 16 * g) = o;
        }
        if (pl) { pool_finish(PI, RGP, pit); pit += NGW; }
    }
    for (; pit < MTOK; pit += NGW) { pool_issue(PI, PU, pit, F.lane); pool_finish(PI, RGP, pit); }
    P3_SYNC();
#undef P3_STAGE
#undef P3_SYNC
}

struct EpiMix {
    static constexpr bool PERM = true; static constexpr int MID_T = 16;
    unsigned char* ws;
    __device__ __forceinline__ void mid(f32x4 (&acc)[2][2][4][2], const pg8::Unit& u, int wr, int wc, int fr, int fq) const {
        const int row0 = u.pm * 256 + wr * 64 + fr, col0 = u.pn * 256 + wc * 32 + 8 * fq;
        const GAS unsigned char* gbase = (const GAS unsigned char*)(ws + WS_GT);
        unsigned goff = (unsigned)(row0 * 2048 + col0) * 2u;
#pragma unroll
        for (int ai = 0; ai < 2; ++ai)
#pragma unroll
            for (int m = 0; m < 4; ++m) {
                asm volatile("" : "+v"(goff));
#pragma unroll
                for (int bj = 0; bj < 2; ++bj) {
                    const GAS unsigned char* gp = gbase + (goff + (unsigned)((ai * 128 + m * 16) * 4096 + bj * 256));
                    const v4u ga = *(const GAS v4u*)gp, gb = *(const GAS v4u*)(gp + 2048);
                    f32x4 r0, r1;
                    r0[0] = bf_lo(ga.x) * __builtin_amdgcn_rcpf(bf_lo(gb.x)); r0[1] = bf_hi(ga.x) * __builtin_amdgcn_rcpf(bf_hi(gb.x)); r0[2] = bf_lo(ga.y) * __builtin_amdgcn_rcpf(bf_lo(gb.y)); r0[3] = bf_hi(ga.y) * __builtin_amdgcn_rcpf(bf_hi(gb.y));
                    r1[0] = bf_lo(ga.z) * __builtin_amdgcn_rcpf(bf_lo(gb.z)); r1[1] = bf_hi(ga.z) * __builtin_amdgcn_rcpf(bf_hi(gb.z)); r1[2] = bf_lo(ga.w) * __builtin_amdgcn_rcpf(bf_lo(gb.w)); r1[3] = bf_hi(ga.w) * __builtin_amdgcn_rcpf(bf_hi(gb.w));
                    acc[ai][bj][m][0] = acc[ai][bj][m][0] * r0; acc[ai][bj][m][1] = acc[ai][bj][m][1] * r1;
                }
                asm volatile("" ::: "memory");
            }
    }
    __device__ __forceinline__ void operator()(const f32x4 (&acc)[2][2][4][2], const pg8::Unit& u, int wr, int wc, int fr, int fq) const {
        const int row0 = u.pm * 256 + wr * 64 + fr, col0 = u.pn * 256 + wc * 32 + 8 * fq;
        const bf16* const GT = (const bf16*)(ws + WS_GT); bf16* const MIX = (bf16*)(ws + WS_MIX);
#pragma unroll
        for (int ai = 0; ai < 2; ++ai)
#pragma unroll
            for (int m = 0; m < 4; ++m)
#pragma unroll
                for (int bj = 0; bj < 2; ++bj) {
                    const size_t row = (size_t)(row0 + ai * 128 + m * 16);
                    const v4u gb = *(const v4u*)(GT + row * 2048 + 1024 + col0 + bj * 128);
                    const f32x4 g0 = {bf_lo(gb.x), bf_hi(gb.x), bf_lo(gb.y), bf_hi(gb.y)}, g1 = {bf_lo(gb.z), bf_hi(gb.z), bf_lo(gb.w), bf_hi(gb.w)};
                    *(v4u*)(MIX + row * DM + col0 + bj * 128) = pack8(acc[ai][bj][m][0] * g0, acc[ai][bj][m][1] * g1);
                }
    }
};
template <bool WITH_B16> struct EpiRes {
    static constexpr bool PERM = false; static constexpr int MID_T = 0;
    unsigned char* ws; const float* xin; float* dout;
    __device__ __forceinline__ void operator()(const f32x4 (&acc)[2][2][4][2], const pg8::Unit& u, int wr, int wc, int fr, int fq) const {
        const int row0 = u.pm * 256 + wr * 64 + fr, col0 = u.pn * 256 + wc * 32 + 4 * fq;
        const float* const base = WITH_B16 ? xin : (const float*)(ws + WS_X1); float* const out = WITH_B16 ? (float*)(ws + WS_X1) : dout; bf16* const ob = (bf16*)(ws + WS_X1B); float* const ss = (float*)(ws + (WITH_B16 ? WS_SS2 : WS_SS3));
#pragma unroll
        for (int ai = 0; ai < 2; ++ai)
#pragma unroll
            for (int m = 0; m < 4; ++m) {
                const int row = row0 + ai * 128 + m * 16; const size_t off = (size_t)row * DM + col0; float s = 0.f;
#pragma unroll
                for (int bj = 0; bj < 2; ++bj)
#pragma unroll
                    for (int n = 0; n < 2; ++n) {
                        const f32x4 o = *(const f32x4*)(base + off + bj * 128 + n * 16) + acc[ai][bj][m][n];
                        *(f32x4*)(out + off + bj * 128 + n * 16) = o; s += (o[0] * o[0] + o[1] * o[1]) + (o[2] * o[2] + o[3] * o[3]);
                        if (WITH_B16) { v2u w; w.x = cvt_pk_bf16(o[0], o[1]); w.y = cvt_pk_bf16(o[2], o[3]); *(v2u*)(ob + off + bj * 128 + n * 16) = w; }
                    }
                s += __shfl_xor(s, 16); s += __shfl_xor(s, 32);
                if (fq == 0) atomicAdd(ss + row, s);
                if (m & 1) asm volatile("" ::: "memory");
            }
    }
};
struct EpiUp {
    static constexpr bool PERM = true; static constexpr int MID_T = 0;
    unsigned char* ws;
    __device__ __forceinline__ void operator()(const f32x4 (&acc)[2][2][4][2], const pg8::Unit& u, int wr, int wc, int fr, int fq) const {
        const int row0 = u.pm * 256 + wr * 64 + fr, col0 = u.pn * 256 + wc * 32 + 8 * fq;
        const float* const ss = (const float*)(ws + WS_SS2); bf16* const HID = (bf16*)(ws + WS_HID);
#pragma unroll
        for (int ai = 0; ai < 2; ++ai)
#pragma unroll
            for (int m = 0; m < 4; ++m) {
                const int row = row0 + ai * 128 + m * 16; const float rstd = 1.0f / sqrtf(ss[row] * (1.0f / DM) + EPS);
#pragma unroll
                for (int bj = 0; bj < 2; ++bj) {
                    f32x4 v[2];
#pragma unroll
                    for (int n = 0; n < 2; ++n)
#pragma unroll
                        for (int j = 0; j < 4; ++j) { const float a = fmaxf(acc[ai][bj][m][n][j] * rstd, 0.f); v[n][j] = a * a; }
                    *(v4u*)(HID + (size_t)row * DFF + col0 + bj * 128) = pack8(v[0], v[1]);
                }
            }
    }
};

typedef const __attribute__((address_space(4))) Args* KArgs;
#define KARGS() ({ KArgs p_ = (KArgs)__builtin_amdgcn_kernarg_segment_ptr(); asm volatile("" : "+s"(p_)); p_; })
__device__ __forceinline__ void frame_init(Frame& F, KArgs ap) {
    extern __shared__ __attribute__((aligned(16))) unsigned char lds[];
    F.lds = (LAS unsigned char*)lds;
    int t_ = threadIdx.x; asm volatile("" : "+v"(t_));
    F.tid = t_; F.lane = t_ & 63; F.wave = __builtin_amdgcn_readfirstlane(t_ >> 6);
    F.G = gridDim.x; { const int bx = blockIdx.x; F.vcu = (F.G % 8 == 0) ? (bx % 8) * (F.G / 8) + bx / 8 : bx; }
    F.ws = ap->ws; F.out = ap->out; F.ctl = (gu32*)(F.ws + WS_CTL);
}
__global__ void __launch_bounds__(NWAVES * 64, 2) skel_fwd(Args args_unused) {
    extern __shared__ __attribute__((aligned(16))) unsigned char lds[];
    {
        LAS unsigned char* L = (LAS unsigned char*)lds;
        for (int u = threadIdx.x; u < (LDS_BYTES - LDSCTL_OFF) / 4; u += NWAVES * 64) ((LAS unsigned*)(L + LDSCTL_OFF))[u] = 0u;
        __syncthreads();
        KArgs ap = KARGS();
        if (N_LAUNCHES == 1 && threadIdx.x == 0) (void)xb_add((unsigned*)(ap->ws + WS_CTL) + CW_BAR + XB_XCNT(xb_xcc_id()), 1u);
    }
#ifdef DBG_STOP
#define IN(k) ({ KArgs q_ = KARGS(); ((k) <= DBG_STOP && q_->ph_lo <= (k) && (k) < q_->ph_hi); })
#else
#define IN(k) ({ KArgs q_ = KARGS(); (q_->ph_lo <= (k) && (k) < q_->ph_hi); })
#endif
#define SEAM(k) do { if (N_LAUNCHES == 1) { KArgs q_ = KARGS(); if (q_->ph_lo <= (k) && (k) + 1 < q_->ph_hi) { XcdBarrier b_; b_.bar = (unsigned*)(q_->ws + WS_CTL) + CW_BAR; b_.x = xb_xcc_id(); \
        b_.st = (volatile LAS unsigned*)((LAS unsigned char*)lds + MISC_OFF) + 8; xcd_barrier(b_); } } } while (0)

#ifdef DBG_STAMP
#define ST_B(k) do { if ((k) == DBG_STAMP && blockIdx.x == 0 && threadIdx.x == 0) ((volatile LAS unsigned*)((LAS unsigned char*)lds + MISC_OFF))[16] = (unsigned)__builtin_amdgcn_s_memrealtime(); } while (0)
#define ST_E(k) do { if ((k) == DBG_STAMP && blockIdx.x == 0 && threadIdx.x == 0) { volatile LAS unsigned* M_ = (volatile LAS unsigned*)((LAS unsigned char*)lds + MISC_OFF); M_[17] = (unsigned)__builtin_amdgcn_s_memrealtime() - M_[16]; } } while (0)
#else
#define ST_B(k) do {} while (0)
#define ST_E(k) do {} while (0)
#endif
    ST_B(0); if (IN(0)) { KArgs ap = KARGS(); Frame F; frame_init(F, ap); p0_prologue(F, ap); } SEAM(0); ST_E(0);

    ST_B(1); if (IN(1)) {
        { KArgs ap = KARGS(); unsigned char* ws = ap->ws;
          pg8::Gemm g{(const bf16*)(ws + WS_XN), (const bf16*)(ws + WS_BT1), MTOK, N1, DM}; pg8::StaticOrder<MTOK, N1> S; S.init((int)gridDim.x, (int)blockIdx.x);
          EpiIn E{ws, ap->in[3]};
          pg8::gemm_phase<EpiIn, pg8::StaticOrder<MTOK, N1>, DM, PG8_ALIGN, PG8_SP2>((LAS unsigned char*)lds + RING_OFF, g, S, E); }
        { KArgs ap = KARGS(); unsigned char* ws = ap->ws;
          pg8::Gemm g{(const bf16*)(ws + WS_WT2), (const bf16*)(ws + WS_XN), M2, MTOK, DM}; pg8::StaticOrder<M2, MTOK> S; S.init((int)gridDim.x, (int)blockIdx.x);
          EpiInT E{ws};
          pg8::gemm_phase<EpiInT, pg8::StaticOrder<M2, MTOK>, DM, PG8_ALIGN, PG8_SP2>((LAS unsigned char*)lds + RING_OFF, g, S, E); }
    } SEAM(1); ST_E(1);

    ST_B(2); if (IN(2)) { KArgs ap = KARGS(); Frame F; frame_init(F, ap); p2_scan(F, ap); } SEAM(2); ST_E(2);

    ST_B(3); if (IN(3)) { KArgs ap = KARGS(); Frame F; frame_init(F, ap); p3_retention(F, ap); } SEAM(3); ST_E(3);

    ST_B(4); if (IN(4)) {
        KArgs ap = KARGS(); unsigned char* ws = ap->ws;
        pg8::Gemm g{(const bf16*)ap->out, (const bf16*)(ws + WS_BT4), MTOK, DM, K4}; pg8::StaticOrder<MTOK, DM> S; S.init((int)gridDim.x, (int)blockIdx.x);
        EpiMix E{ws};
        pg8::gemm_phase<EpiMix, pg8::StaticOrder<MTOK, DM>, K4, PG8_ALIGN, PG8_SP2>((LAS unsigned char*)lds + RING_OFF, g, S, E);
    } SEAM(4); ST_E(4);

    ST_B(5); if (IN(5)) {
        KArgs ap = KARGS(); unsigned char* ws = ap->ws;
        pg8::Gemm g{(const bf16*)(ws + WS_MIX), (const bf16*)(ws + WS_BT5), MTOK, DM, DM}; pg8::StaticOrder<MTOK, DM> S; S.init((int)gridDim.x, (int)blockIdx.x);
        EpiRes<true> E{ws, ap->in[0], nullptr};
        pg8::gemm_phase<EpiRes<true>, pg8::StaticOrder<MTOK, DM>, DM, PG8_ALIGN, PG8_SP2>((LAS unsigned char*)lds + RING_OFF, g, S, E);
    } SEAM(5); ST_E(5);

    ST_B(6); if (IN(6)) {
        KArgs ap = KARGS(); unsigned char* ws = ap->ws;
        pg8::Gemm g{(const bf16*)(ws + WS_X1B), (const bf16*)(ws + WS_BT6), MTOK, DFF, DM}; pg8::StaticOrder<MTOK, DFF> S; S.init((int)gridDim.x, (int)blockIdx.x);
        EpiUp E{ws};
        pg8::gemm_phase<EpiUp, pg8::StaticOrder<MTOK, DFF>, DM, PG8_ALIGN, PG8_SP2>((LAS unsigned char*)lds + RING_OFF, g, S, E);
    } SEAM(6); ST_E(6);

    ST_B(7); if (IN(7)) {
        KArgs ap = KARGS(); unsigned char* ws = ap->ws;
        pg8::Gemm g{(const bf16*)(ws + WS_HID), (const bf16*)(ws + WS_BT7), MTOK, DM, DFF}; pg8::StaticOrder<MTOK, DM> S; S.init((int)gridDim.x, (int)blockIdx.x);
        EpiRes<false> E{ws, nullptr, ap->out};
        pg8::gemm_phase<EpiRes<false>, pg8::StaticOrder<MTOK, DM>, DFF, PG8_ALIGN, PG8_SP2>((LAS unsigned char*)lds + RING_OFF, g, S, E);
    } SEAM(7); ST_E(7);

    ST_B(8); if (IN(8)) {
        KArgs ap = KARGS(); Frame F; frame_init(F, ap);
        const float* lnf = ap->in[13]; const float* ss = (const float*)(F.ws + WS_SS3); float* outp = F.out;
        const int gw = F.vcu * NWAVES + F.wave, NGW = F.G * NWAVES;
        unsigned bad = (N_LAUNCHES == 1) ? (xb_ld((unsigned*)(F.ctl + CW_BAR) + XB_TMO) != 0u) : 0u;
        const float qn = __builtin_nanf("");
        f32x4 gv[4];
#pragma unroll
        for (int j = 0; j < 4; ++j) gv[j] = ((const GAS f32x4*)lnf)[64 * j + F.lane];
        for (int m = gw; m < MTOK; m += NGW) {
            GAS f32x4* o = (GAS f32x4*)(outp + (size_t)m * DM) + F.lane; const float rstd = 1.0f / sqrtf(ss[m] * (1.0f / DM) + EPS);
#pragma unroll
            for (int j = 0; j < 4; ++j) { f32x4 v = o[64 * j] * rstd * gv[j]; if (bad) v = (f32x4){qn, qn, qn, qn}; o[64 * j] = v; }
        }
    }
#ifdef DBG_STOP
    {
        KArgs ap = KARGS();
        if (ap->ph_hi == N_PHASES) {
            Frame F; frame_init(F, ap); const unsigned char* ws = F.ws; float* outp = F.out;
            const int gt = F.vcu * NWAVES * 64 + F.tid, NGT = F.G * NWAVES * 64;
            const size_t M16 = (size_t)1 << 24;
            for (size_t i = (DBG_STOP == 2 || DBG_STOP == 3) ? (size_t)gt + 25165824 : (size_t)gt; i < (size_t)MTOK * DM; i += NGT) {
                float v = 0.f;
#define BF(off, cnt) bf_lo((unsigned)((const bf16*)(ws + (off)))[i % (cnt)])
                if (DBG_STOP == 0) { v = BF(WS_XN, 2 * M16) + BF(WS_BT1, 4608 * 1024) + BF(WS_WT2, 1536 * 1024) + BF(WS_BT4, 1536 * 1024) + BF(WS_BT5, 1024 * 1024) + BF(WS_BT6, 4096 * 1024) + BF(WS_BT7, 4096 * 1024)
                                       + ((const float*)(ws + WS_T1))[i % (4096 * 128)] + ((const float*)(ws + WS_T2C))[i % (4096 * 64)] + ((const float*)(ws + WS_T2S))[i % (4096 * 64)] + ((const float*)(ws + WS_DEC))[i % 512]; }
                if (DBG_STOP == 1) { v = BF(WS_Q, M16) + BF(WS_K, M16) + BF(WS_KT, M16) + BF(WS_VS, 2 * M16) + BF(WS_SG, 2 * M16) + BF(WS_PU, M16) + BF(WS_GT, 4 * M16); }
                if (DBG_STOP == 2 || DBG_STOP == 3) { v = BF(WS_ST, 2 * M16); }
                if (DBG_STOP == 4) { v = BF(WS_MIX, 2 * M16); }
                if (DBG_STOP == 5) { v = BF(WS_X1B, 2 * M16) + ((const float*)(ws + WS_SS2))[i % MTOK]; }
                if (DBG_STOP == 6) { v = BF(WS_HID, 8 * M16); }
                outp[i] = v;
            }
        }
    }
#endif
    ST_E(8);
#ifdef DBG_STAMP
    { __syncthreads(); KArgs ap = KARGS(); if (blockIdx.x == 0 && threadIdx.x == 0) { asm volatile("s_waitcnt vmcnt(0)" ::: "memory"); ap->out[0] = 10.0f * __builtin_rintf((float)((volatile LAS unsigned*)((LAS unsigned char*)lds + MISC_OFF))[17] * 0.001f); } }
#endif
#undef IN
#undef SEAM
}

extern "C" void kernel_launch(void* const* d_in, const int* in_sizes, int n_in, void* d_out, int out_size, void* d_ws, size_t ws_size, hipStream_t stream) {
    static int grid = 0;
    if (grid == 0) {
        if (n_in != 14 || in_sizes[0] != MTOK * DM || out_size != MTOK * DM || ws_size < WS_END) { fprintf(stderr, "kernel_launch: unexpected shapes (n_in %d, in0 %d, out %d, ws %zu); nothing launched\n", n_in, n_in > 0 ? in_sizes[0] : -1, out_size, ws_size); grid = -1; return; }
        int dev = 0, cus = 0, per_cu = 0;
        if (hipGetDevice(&dev) != hipSuccess || hipDeviceGetAttribute(&cus, hipDeviceAttributeMultiprocessorCount, dev) != hipSuccess) { fprintf(stderr, "kernel_launch: device query failed\n"); grid = -1; return; }
        if (hipFuncSetAttribute((const void*)skel_fwd, hipFuncAttributeMaxDynamicSharedMemorySize, LDS_BYTES) != hipSuccess) { fprintf(stderr, "kernel_launch: hipFuncSetAttribute failed\n"); grid = -1; return; }
        if (hipOccupancyMaxActiveBlocksPerMultiprocessor(&per_cu, (const void*)skel_fwd, NWAVES * 64, LDS_BYTES) != hipSuccess || per_cu < 1) fprintf(stderr, "kernel_launch: occupancy query reports %d workgroups per CU\n", per_cu);
        (void)hipGetLastError();
        grid = cus;
    }
    if (grid < 0) return;
    (void)hipMemsetAsync((char*)d_ws + WS_CTL, 0, CTL_ZERO_BYTES, stream);
    Args a{};
    for (int i = 0; i < 14; ++i) a.in[i] = (const float*)d_in[i];
    a.out = (float*)d_out; a.ws = (unsigned char*)d_ws;
    for (int d = 0; d < 64; ++d) a.invf[d] = std::pow(10000.0, -(double)d / 64.0);
    for (int h = 0; h < 4; ++h) { const double gam = 1.0 - std::exp2(-5.0 - h), lgm = std::log(gam); a.lg[h] = (float)lgm; a.g1[h] = (float)gam; a.g127[h] = (float)std::exp(127.0 * lgm); a.g128[h] = (float)std::exp(128.0 * lgm); }
    if (N_LAUNCHES == 1) { a.ph_lo = 0; a.ph_hi = N_PHASES; hipLaunchKernelGGL(skel_fwd, dim3(grid), dim3(NWAVES * 64), LDS_BYTES, stream, a); }
    else for (int p = 0; p < N_PHASES; ++p) { a.ph_lo = p; a.ph_hi = p + 1; hipLaunchKernelGGL(skel_fwd, dim3(grid), dim3(NWAVES * 64), LDS_BYTES, stream, a); }
}
```
